# Optimizing an MI355X kernel written in HIP

```python
import jax, jax.numpy as jnp
from jax import lax
import numpy as np

D_MODEL = 1024
BATCH = 4
SEQ = 8192
DEPTH = 4

GRID_W = 64
CTX_LEN = 256
MIX_WIDTH = D_MODEL
ATTN_WIDTH = MIX_WIDTH // 2
POOL_WIDTH = MIX_WIDTH // 4
CONV_WIDTH = MIX_WIDTH - ATTN_WIDTH - POOL_WIDTH
NOPE_DIM = 128
ROPE_DIM = 64
V_DIM = 128
MLA_HEADS = ATTN_WIDTH // V_DIM
Q_RANK = D_MODEL // 4
KV_RANK = D_MODEL // 8
QK_DIM = NOPE_DIM + ROPE_DIM
SOFTMAX_SCALE = QK_DIM ** -0.5
ROPE_THETA = 10000.0
POOL_WINDOWS = (2, 4, 8, 16)
POOL_GROUPS = len(POOL_WINDOWS)
POOL_CH = POOL_WIDTH // POOL_GROUPS
CONV_K = 3
D_FF = ((8 * D_MODEL // 3 + 127) // 128) * 128
Q_BLOCK = 128
EPS = 1e-6
IN_SIZES = (Q_RANK, KV_RANK, ROPE_DIM, POOL_WIDTH, CONV_WIDTH, CONV_WIDTH, CONV_WIDTH)
IN_WIDTH = sum(IN_SIZES)
IN_SPLITS = tuple(int(s) for s in np.cumsum(IN_SIZES)[:-1])

kernel_name = 'hybrid_mla_pool_shortconv_dit'


def rmsnorm(x, g):
    xf = x.astype(jnp.float32)
    y = xf * lax.rsqrt(jnp.mean(xf * xf, axis=-1, keepdims=True) + EPS)
    return (y * g.astype(jnp.float32)).astype(x.dtype)


def adaln(cvec, w, b):
    m = jax.nn.silu(cvec) @ w + b
    m = m.reshape(-1, 1, 6 * D_MODEL)
    return jnp.split(m, 6, axis=-1)


def axial_rope_tables(n_tokens):
    rows = n_tokens // GRID_W
    row = jnp.repeat(jnp.arange(rows), GRID_W).astype(jnp.float32)
    col = jnp.tile(jnp.arange(GRID_W), rows).astype(jnp.float32)
    n_freq = ROPE_DIM // 4
    inv = ROPE_THETA ** (-jnp.arange(n_freq, dtype=jnp.float32) / n_freq)
    ar = row[:, None] * inv
    ac = col[:, None] * inv
    ang = jnp.concatenate([ar, ar, ac, ac], axis=-1)
    return jnp.cos(ang), jnp.sin(ang)


def apply_axial_rope(x, cos, sin):
    n_freq = ROPE_DIM // 4
    xr = x.reshape(x.shape[:-1] + (2, 2, n_freq))
    rot = jnp.stack([-xr[..., 1, :], xr[..., 0, :]], axis=-2).reshape(x.shape)
    return x * cos.astype(x.dtype) + rot * sin.astype(x.dtype)


def dwconv3(u, w):
    up = jnp.pad(u, ((0, 0), (1, 1), (0, 0)))
    return up[:, :-2] * w[0] + up[:, 1:-1] * w[1] + up[:, 2:] * w[2]


def mixer_features(h, w_in, qc_g, kvc_g, w_q_up, w_kv_up, qn_g, qr_g, kn_g, kr_g, rope):
    b, n, _ = h.shape
    q_lat, kv_lat, k_rope, pool_in, gate_b, gate_c, conv_in = jnp.split(h @ w_in, IN_SPLITS, axis=-1)
    q = (rmsnorm(q_lat, qc_g) @ w_q_up).reshape(b, n, MLA_HEADS, QK_DIM)
    kv = (rmsnorm(kv_lat, kvc_g) @ w_kv_up).reshape(b, n, MLA_HEADS, NOPE_DIM + V_DIM)
    q_nope = rmsnorm(q[..., :NOPE_DIM], qn_g)
    q_rope = rmsnorm(q[..., NOPE_DIM:], qr_g)
    k_nope = rmsnorm(kv[..., :NOPE_DIM], kn_g)
    v = kv[..., NOPE_DIM:]
    k_rope = rmsnorm(k_rope, kr_g)
    if rope is not None:
        cos, sin = rope
        q_rope = apply_axial_rope(q_rope, cos[:, None, :], sin[:, None, :])
        k_rope = apply_axial_rope(k_rope, cos, sin)
    attn_in = (q_nope * SOFTMAX_SCALE, q_rope * SOFTMAX_SCALE, k_nope, k_rope, v)
    return attn_in, (pool_in, gate_b, gate_c, conv_in)


def attend(q_nope, q_rope, k_nope, k_rope, v):
    s = jnp.einsum('bqhd,bkhd->bhqk', q_nope, k_nope) + jnp.einsum('bqhr,bkr->bhqk', q_rope, k_rope)
    p = jax.nn.softmax(s.astype(jnp.float32), axis=-1).astype(v.dtype)
    o = jnp.einsum('bhqk,bkhd->bqhd', p, v)
    return o.reshape(o.shape[0], o.shape[1], ATTN_WIDTH)


def blocked_attention(q_nope, q_rope, k_nope, k_rope, v):
    b, n = q_nope.shape[:2]
    nblk = n // Q_BLOCK
    qn = q_nope.reshape(b, nblk, Q_BLOCK, MLA_HEADS, NOPE_DIM).swapaxes(0, 1)
    qr = q_rope.reshape(b, nblk, Q_BLOCK, MLA_HEADS, ROPE_DIM).swapaxes(0, 1)
    o = lax.map(lambda qs: attend(qs[0], qs[1], k_nope, k_rope, v), (qn, qr))
    return o.swapaxes(0, 1).reshape(b, n, ATTN_WIDTH)


def multiscale_pool(p, w, scale):
    b, n, _ = p.shape
    cs = jnp.pad(jnp.cumsum(p.astype(jnp.float32), axis=1), ((0, 0), (1, 0), (0, 0)))
    t = jnp.arange(n)
    means = []
    for g, win in enumerate(POOL_WINDOWS):
        lo = jnp.clip(t - win // 2, 0, n)
        hi = jnp.clip(t + win // 2, 0, n)
        csg = cs[..., g * POOL_CH:(g + 1) * POOL_CH]
        total = jnp.take(csg, hi, axis=1) - jnp.take(csg, lo, axis=1)
        means.append(total / (hi - lo).astype(jnp.float32)[None, :, None])
    pooled = jnp.stack(means, axis=2).astype(p.dtype)
    diff = pooled - p.reshape(b, n, POOL_GROUPS, POOL_CH)
    y = jnp.einsum('bngc,gcd->bngd', diff, w).reshape(b, n, POOL_WIDTH)
    return y * scale


def mixer_output(attn, other, pool_w, pool_scale, sconv_w, w_o):
    pool_in, gate_b, gate_c, conv_in = other
    pool_out = multiscale_pool(pool_in, pool_w, pool_scale)
    conv_out = gate_b * dwconv3(gate_c * conv_in, sconv_w)
    return jnp.concatenate([attn, pool_out, conv_out], axis=-1) @ w_o


def conv_ffn(h, w_up, w_conv, w_down):
    g, u = jnp.split(h @ w_up, 2, axis=-1)
    return (jax.nn.silu(dwconv3(g, w_conv)) * u) @ w_down


def setup_inputs(seed: int = 0) -> dict:
    key = jax.random.key(seed)
    ks = jax.random.split(key, 24)

    def nrm(k, shape, s):
        return jax.random.normal(k, shape, jnp.float32) * s

    def gain(k, shape):
        return 1.0 + 0.1 * jax.random.normal(k, shape, jnp.float32)

    return {
        'x': nrm(ks[0], (BATCH, SEQ, D_MODEL), 1.0),
        'c': nrm(ks[1], (BATCH, D_MODEL), 1.0),
        'ctx': nrm(ks[2], (BATCH, CTX_LEN, D_MODEL), 1.0),
        'c_ctx': nrm(ks[3], (D_MODEL,), 1.0),
        'ada_w': nrm(ks[4], (DEPTH, D_MODEL, 6 * D_MODEL), 0.5 * D_MODEL ** -0.5),
        'ada_b': nrm(ks[5], (DEPTH, 6 * D_MODEL), 0.02),
        'norm1_g': gain(ks[6], (DEPTH, D_MODEL)),
        'norm2_g': gain(ks[7], (DEPTH, D_MODEL)),
        'w_in': nrm(ks[8], (DEPTH, D_MODEL, IN_WIDTH), D_MODEL ** -0.5),
        'qc_g': gain(ks[9], (DEPTH, Q_RANK)),
        'kvc_g': gain(ks[10], (DEPTH, KV_RANK)),
        'w_q_up': nrm(ks[11], (DEPTH, Q_RANK, MLA_HEADS * QK_DIM), Q_RANK ** -0.5),
        'w_kv_up': nrm(ks[12], (DEPTH, KV_RANK, MLA_HEADS * (NOPE_DIM + V_DIM)), KV_RANK ** -0.5),
        'qn_g': gain(ks[13], (DEPTH, NOPE_DIM)),
        'qr_g': gain(ks[14], (DEPTH, ROPE_DIM)),
        'kn_g': gain(ks[15], (DEPTH, NOPE_DIM)),
        'kr_g': gain(ks[16], (DEPTH, ROPE_DIM)),
        'pool_w': nrm(ks[17], (DEPTH, POOL_GROUPS, POOL_CH, POOL_CH), POOL_CH ** -0.5),
        'pool_scale': gain(ks[18], (DEPTH, POOL_WIDTH)),
        'sconv_w': nrm(ks[19], (DEPTH, CONV_K, CONV_WIDTH), CONV_K ** -0.5),
        'w_o': nrm(ks[20], (DEPTH, MIX_WIDTH, D_MODEL), MIX_WIDTH ** -0.5),
        'ff_up': nrm(ks[21], (DEPTH, D_MODEL, 2 * D_FF), D_MODEL ** -0.5),
        'ff_conv': nrm(ks[22], (DEPTH, CONV_K, D_FF), CONV_K ** -0.5),
        'ff_down': nrm(ks[23], (DEPTH, D_FF, D_MODEL), D_FF ** -0.5),
    }


def reference(x, c, ctx, c_ctx, ada_w, ada_b, norm1_g, norm2_g, w_in, qc_g, kvc_g, w_q_up, w_kv_up,
              qn_g, qr_g, kn_g, kr_g, pool_w, pool_scale, sconv_w, w_o, ff_up, ff_conv, ff_down):
    n = x.shape[1]
    rope = axial_rope_tables(n)
    for i in range(DEPTH):
        feat_w = (w_in[i], qc_g[i], kvc_g[i], w_q_up[i], w_kv_up[i], qn_g[i], qr_g[i], kn_g[i], kr_g[i])
        out_w = (pool_w[i], pool_scale[i], sconv_w[i], w_o[i])
        ffn_w = (ff_up[i], ff_conv[i], ff_down[i])
        sh1x, sc1x, g1x, sh2x, sc2x, g2x = adaln(c, ada_w[i], ada_b[i])
        sh1c, sc1c, g1c, sh2c, sc2c, g2c = adaln(c_ctx, ada_w[i], ada_b[i])

        hx = rmsnorm(x, norm1_g[i]) * (1 + sc1x) + sh1x
        hc = rmsnorm(ctx, norm1_g[i]) * (1 + sc1c) + sh1c
        (qn_x, qr_x, kn_x, kr_x, v_x), rest_x = mixer_features(hx, *feat_w, rope)
        (qn_c, qr_c, kn_c, kr_c, v_c), rest_c = mixer_features(hc, *feat_w, None)

        k_nope = jnp.concatenate([kn_x, kn_c], axis=1)
        k_rope = jnp.concatenate([kr_x, kr_c], axis=1)
        v = jnp.concatenate([v_x, v_c], axis=1)
        attn_x = blocked_attention(qn_x, qr_x, k_nope, k_rope, v)
        x = x + g1x * mixer_output(attn_x, rest_x, *out_w)
        x = x + g2x * conv_ffn(rmsnorm(x, norm2_g[i]) * (1 + sc2x) + sh2x, *ffn_w)

        if i < DEPTH - 1:
            attn_c = attend(qn_c, qr_c, kn_c, kr_c, v_c)
            ctx = ctx + g1c * mixer_output(attn_c, rest_c, *out_w)
            ctx = ctx + g2c * conv_ffn(rmsnorm(ctx, norm2_g[i]) * (1 + sc2c) + sh2c, *ffn_w)
    return x
```

```cpp
#include <hip/hip_runtime.h>
#include <hip/hip_cooperative_groups.h>
#include <cstdio>
#include <cstdint>
namespace cg = cooperative_groups;

constexpr int DM = 1024, NB = 4, SEQ = 8192, DEPTH = 4, CTXL = 256;
constexpr int TLAT = NB * SEQ, TCTX = NB * CTXL, TT = TLAT + TCTX;
constexpr int INW = 1472, INP = 1536, QRK = 256, KVRK = 128, NHEAD = 4, DQK = 192, DFF = 2816;
constexpr float EPSN = 1e-6f;
__device__ __forceinline__ int tidx() { int t = (int)__builtin_amdgcn_workitem_id_x(); asm volatile("" : "+v"(t)); return t; }
namespace pg8 {
#define PG8_LAS __attribute__((address_space(3)))
typedef unsigned short bf16_t;
typedef short bf16x8 __attribute__((ext_vector_type(8)));
typedef float f32x4 __attribute__((ext_vector_type(4)));
typedef unsigned u32x4 __attribute__((ext_vector_type(4)));
constexpr int BM = 256, BK = 64, HALF = 128, HTB = HALF * BK * 2  , STAGE_BYTES = 8 * HTB, NXCD = 8, WGM = 8;

__host__ __device__ __forceinline__ int lds_byte(int r, int c) { const int st = (r >> 4) * 2 + (c >> 5), rr = r & 15, cc = c & 31, ob = rr * 64 + cc * 2; return st * 1024 + (ob ^ (((ob >> 9) & 1) << 5)); }
__host__ __device__ __forceinline__ void stage_rc(int b, int& R, int& C) { const int st = b / 1024, sb = b % 1024, swz = sb ^ (((sb >> 9) & 1) << 5); R = (st >> 1) * 16 + swz / 64; C = (st & 1) * 32 + (swz % 64) / 2; }
__host__ __device__ __forceinline__ int perm32(int rho) { const int n = rho >> 4, i = rho & 15; return 8 * (i >> 2) + 4 * n + (i & 3); }

struct Unit { int pm, pn, ks; };
struct Gemm { const bf16_t* A; const bf16_t* Bt; int M, N, K, ld; };

struct StaticOrder {
    int nM, nN, nwg, G, c;
    __host__ __device__ void init(int M, int N, int G_, int c_) { nM = M / BM; nN = N / BM; nwg = nM * nN; G = G_; c = c_; }
    int nsplit = 1, pm0 = 0;
    __host__ __device__ bool next(int i, Unit& u) const {
        if (nsplit > 1) { const long Ls = (long)i * G + c; if (Ls >= (long)nwg * nsplit) return false; const int t = (int)(Ls / nsplit); u.ks = (int)(Ls % nsplit); u.pn = t % nN; u.pm = pm0 + t / nN; return true; }
        const long L = (long)i * G + c; if (L >= nwg) return false;
        int wgid = (int)L; { const int q = nwg / NXCD, r = nwg % NXCD, xcd = wgid % NXCD, off = wgid / NXCD; wgid = (xcd < r ? xcd * (q + 1) : r * (q + 1) + (xcd - r) * q) + off; }
        const int nig = WGM * nN, gid = wgid / nig, fm = gid * WGM, gsz = (nM - fm) < WGM ? (nM - fm) : WGM;
        u.pm = fm + ((wgid % nig) % gsz); u.pn = (wgid % nig) / gsz; u.ks = 0; return true;
    }
    __device__ __forceinline__ void a_ready(const Unit&) const {}
    __device__ __forceinline__ void done(const Unit&) const {}
};

__device__ __forceinline__ unsigned cvt_pk_bf16(float lo, float hi) { unsigned r; asm volatile("v_cvt_pk_bf16_f32 %0, %1, %2" : "=v"(r) : "v"(lo), "v"(hi)); return r; }
template <class Epi, class Sched, bool ALIGN_EPI = false, bool SP2 = false>
__device__ __forceinline__ void gemm_phase(PG8_LAS unsigned char* lds, const Gemm g, const Sched& S, const Epi& E) {
    const int tid = tidx(), wid = __builtin_amdgcn_readfirstlane(tid >> 6), lane = tid & 63, wr = wid >> 2, wc = wid & 3, fr = lane & 15, fq = lane >> 4;
    const int K = g.K, nt = K / BK;
    unsigned voffA[2], voffB[2];
#pragma unroll
    for (int i = 0; i < 2; ++i) { int R, C; stage_rc(tid * 16 + i * 8192, R, C); const int Rb = Epi::PERM ? ((R & ~31) + perm32(R & 31)) : R;
        voffA[i] = (unsigned)(R * g.ld + C) * 2u; voffB[i] = (unsigned)(Rb * g.ld + C) * 2u; }
    const size_t kstep = (size_t)(BK * 2);
    const size_t hstep = (size_t)HALF * g.ld * 2, kslice = (size_t)K * 2;
    const size_t tstep = 2 * hstep;
    const unsigned ldsw = (unsigned)wid * 1024u;
    const int aoff = lds_byte(wr * 64 + fr, fq * 8), boff = lds_byte(wc * 32 + fr, fq * 8);
#define PG8_SA(b, h) (((b) * 2 + (h)) * HTB)
#define PG8_SB(b, h) ((4 + (b) * 2 + (h)) * HTB)
#define PG8_STAGE(bufoff, gbase, voff) do { _Pragma("unroll") for (int _i = 0; _i < 2; ++_i) \
        __builtin_amdgcn_global_load_lds((const unsigned*)((const char*)(gbase) + (voff)[_i]), (PG8_LAS unsigned*)(lds + (bufoff) + ldsw + _i * 8192), 16, 0, 0); } while (0)
#define PG8_LDA(dst, b, h) do { _Pragma("unroll") for (int m = 0; m < 4; ++m) _Pragma("unroll") for (int k = 0; k < 2; ++k) dst[m][k] = *(const PG8_LAS bf16x8*)(lds + PG8_SA(b, h) + aoff + m * 2048 + k * 1024); } while (0)
#define PG8_LDB(dst, b, h) do { _Pragma("unroll") for (int n = 0; n < 2; ++n) _Pragma("unroll") for (int k = 0; k < 2; ++k) dst[n][k] = *(const PG8_LAS bf16x8*)(lds + PG8_SB(b, h) + boff + n * 2048 + k * 1024); } while (0)
#define PG8_MMA(ai, bj, At, Bt) do { __builtin_amdgcn_s_setprio(1); _Pragma("unroll") for (int m = 0; m < 4; ++m) _Pragma("unroll") for (int n = 0; n < 2; ++n) _Pragma("unroll") for (int k = 0; k < 2; ++k) \
        acc[ai][bj][m][n] = __builtin_amdgcn_mfma_f32_16x16x32_bf16(Bt[n][k], At[m][k], acc[ai][bj][m][n], 0, 0, 0); __builtin_amdgcn_s_setprio(0); } while (0)
#define PG8_WAIT_V(n) asm volatile("s_waitcnt vmcnt(" #n ")" ::: "memory")
#define PG8_WAIT_L(n) asm volatile("s_waitcnt lgkmcnt(" #n ")" ::: "memory")
#define PG8_BAR __builtin_amdgcn_s_barrier()
#define PG8_SCHED __builtin_amdgcn_sched_barrier(0)
    Unit cur, nxt; int ui = 0;
    if (!S.next(0, cur)) return;
    f32x4 acc[2][2][4][2];
#pragma unroll
    for (int a = 0; a < 2; ++a)
#pragma unroll
        for (int b = 0; b < 2; ++b)
#pragma unroll
            for (int m = 0; m < 4; ++m)
#pragma unroll
                for (int n = 0; n < 2; ++n) acc[a][b][m][n] = (f32x4){0.f, 0.f, 0.f, 0.f};
    bf16x8 At[4][2], B0[2][2], B1[2][2];
    const char* cA = (const char*)g.A + (size_t)cur.pm * tstep + cur.ks * kslice; const char* cB = (const char*)g.Bt + (size_t)cur.pn * tstep + cur.ks * kslice;
    S.a_ready(cur);
    if constexpr (SP2) {
        PG8_STAGE(PG8_SB(0, 0), cB, voffB); PG8_STAGE(PG8_SB(0, 1), cB + hstep, voffB); PG8_STAGE(PG8_SA(0, 0), cA, voffA); PG8_STAGE(PG8_SA(0, 1), cA + hstep, voffA);
        if (wr == 1) PG8_BAR;
        PG8_WAIT_V(2); PG8_BAR;
        PG8_STAGE(PG8_SB(1, 0), cB + kstep, voffB); PG8_STAGE(PG8_SA(1, 0), cA + kstep, voffA); PG8_STAGE(PG8_SB(1, 1), cB + hstep + kstep, voffB);
        PG8_WAIT_V(6); PG8_BAR;
    } else {
        PG8_STAGE(PG8_SB(0, 0), cB, voffB); PG8_STAGE(PG8_SA(0, 0), cA, voffA); PG8_STAGE(PG8_SB(0, 1), cB + hstep, voffB); PG8_STAGE(PG8_SA(0, 1), cA + hstep, voffA);
        if (wr == 1) PG8_BAR;
        PG8_WAIT_V(4); PG8_BAR;
        PG8_STAGE(PG8_SB(1, 0), cB + kstep, voffB); PG8_STAGE(PG8_SA(1, 0), cA + kstep, voffA); PG8_STAGE(PG8_SB(1, 1), cB + hstep + kstep, voffB);
        PG8_WAIT_V(6); PG8_BAR;
    }
    for (;;) {
        const bool has_next = S.next(ui + 1, nxt);
        const char* nA = has_next ? (const char*)g.A + (size_t)nxt.pm * tstep + nxt.ks * kslice : cA; const char* nB = has_next ? (const char*)g.Bt + (size_t)nxt.pn * tstep + nxt.ks * kslice : cB;
        for (int t = 0; t < nt; t += 2) {
            const bool last = (t == nt - 2);
            const char* a1 = cA + (size_t)(t + 1) * kstep;
            const char* a2 = last ? nA : cA + (size_t)(t + 2) * kstep; const char* b2 = last ? nB : cB + (size_t)(t + 2) * kstep;
            const char* a3 = a2 + kstep; const char* b3 = b2 + kstep;
            if (last && has_next) S.a_ready(nxt);
            if constexpr (SP2) {
            PG8_LDB(B0, 0, 0); PG8_LDB(B1, 0, 1); PG8_SCHED; PG8_LDA(At, 0, 0); PG8_STAGE(PG8_SA(1, 1), a1 + hstep, voffA);
            PG8_WAIT_V(8); PG8_WAIT_L(0); PG8_BAR; PG8_MMA(0, 0, At, B0); PG8_MMA(0, 1, At, B1); PG8_BAR; PG8_SCHED;
            PG8_LDA(At, 0, 1); PG8_STAGE(PG8_SB(0, 0), b2, voffB); PG8_STAGE(PG8_SB(0, 1), b2 + hstep, voffB); PG8_STAGE(PG8_SA(0, 0), a2, voffA);
            PG8_WAIT_V(8); PG8_WAIT_L(0); PG8_BAR; PG8_MMA(1, 0, At, B0); PG8_MMA(1, 1, At, B1); PG8_BAR; PG8_SCHED;
            PG8_LDB(B0, 1, 0); PG8_LDB(B1, 1, 1); PG8_SCHED; PG8_LDA(At, 1, 0); PG8_STAGE(PG8_SA(0, 1), a2 + hstep, voffA);
            PG8_WAIT_V(8); PG8_WAIT_L(0); PG8_BAR; PG8_MMA(0, 0, At, B0); PG8_MMA(0, 1, At, B1); PG8_BAR; PG8_SCHED;
            PG8_LDA(At, 1, 1); PG8_STAGE(PG8_SB(1, 0), b3, voffB); PG8_STAGE(PG8_SB(1, 1), b3 + hstep, voffB); PG8_STAGE(PG8_SA(1, 0), a3, voffA);
            PG8_WAIT_V(8); PG8_WAIT_L(0); PG8_BAR; PG8_MMA(1, 0, At, B0); PG8_MMA(1, 1, At, B1); PG8_BAR; PG8_SCHED;
            } else {
            PG8_LDB(B0, 0, 0); PG8_SCHED; PG8_LDA(At, 0, 0); PG8_STAGE(PG8_SA(1, 1), a1 + hstep, voffA);
            PG8_WAIT_L(8); PG8_BAR; PG8_WAIT_L(0); PG8_MMA(0, 0, At, B0); PG8_BAR; PG8_SCHED;
            PG8_LDB(B1, 0, 1); PG8_STAGE(PG8_SB(0, 0), b2, voffB);
            PG8_BAR; PG8_WAIT_L(0); PG8_MMA(0, 1, At, B1); PG8_BAR;
            PG8_LDA(At, 0, 1); PG8_STAGE(PG8_SA(0, 0), a2, voffA);
            PG8_BAR; PG8_WAIT_L(0); PG8_MMA(1, 0, At, B0); PG8_BAR; PG8_SCHED;
            PG8_STAGE(PG8_SB(0, 1), b2 + hstep, voffB);
            PG8_WAIT_V(6); PG8_BAR; PG8_MMA(1, 1, At, B1); PG8_BAR;
            PG8_LDB(B0, 1, 0); PG8_SCHED; PG8_LDA(At, 1, 0); PG8_STAGE(PG8_SA(0, 1), a2 + hstep, voffA);
            PG8_WAIT_L(8); PG8_BAR; PG8_WAIT_L(0); PG8_MMA(0, 0, At, B0); PG8_BAR; PG8_SCHED;
            PG8_LDB(B1, 1, 1); PG8_STAGE(PG8_SB(1, 0), b3, voffB);
            PG8_BAR; PG8_WAIT_L(0); PG8_MMA(0, 1, At, B1); PG8_BAR;
            PG8_LDA(At, 1, 1); PG8_STAGE(PG8_SA(1, 0), a3, voffA);
            PG8_BAR; PG8_WAIT_L(0); PG8_MMA(1, 0, At, B0); PG8_BAR; PG8_SCHED;
            PG8_STAGE(PG8_SB(1, 1), b3 + hstep, voffB);
            PG8_WAIT_V(6); PG8_BAR; PG8_MMA(1, 1, At, B1); PG8_BAR;
            }
        }
        if constexpr (ALIGN_EPI) { if (wr == 0) PG8_BAR; }
        if constexpr (!Epi::AFTER_DRAIN) { E(acc, cur, wr, wc, fr, fq); S.done(cur); }
        if (!has_next) break;
#pragma unroll
        for (int a = 0; a < 2; ++a)
#pragma unroll
            for (int b = 0; b < 2; ++b)
#pragma unroll
                for (int m = 0; m < 4; ++m)
#pragma unroll
                    for (int n = 0; n < 2; ++n) acc[a][b][m][n] = (f32x4){0.f, 0.f, 0.f, 0.f};
        cur = nxt; cA = nA; cB = nB; ++ui;
        if constexpr (ALIGN_EPI) { if (wr == 1) PG8_BAR; }
    }
    PG8_WAIT_V(0);
    if constexpr (!ALIGN_EPI) { if (wr == 0) PG8_BAR; }
    PG8_BAR;
    if constexpr (Epi::AFTER_DRAIN) { E.fused(acc, cur, wr, wc, fr, fq, lds, wid, lane); S.done(cur); }
#undef PG8_SA
#undef PG8_SB
#undef PG8_STAGE
#undef PG8_LDA
#undef PG8_LDB
#undef PG8_MMA
#undef PG8_WAIT_V
#undef PG8_WAIT_L
#undef PG8_BAR
#undef PG8_SCHED
}
}
namespace att {
typedef unsigned short bf16;
constexpr int NW = 8, QBLK = 32, KVBLK = 64;
constexpr float SCALE = 0.07216878364870323f;
constexpr float THR = 8.f;
constexpr int LDQ = 768, LDKN = 1024, LDKR = 64, LDV = 1024, LDO = 1024;
constexpr int SHM_V = KVBLK * 128 * 2, SHM_K = KVBLK * 192 * 2, QS_OFF = 3 * SHM_V + 3 * SHM_K + NW * 64 * 4, ATTN_LDS = QS_OFF + 512 * 4 * 16;
using bf16x8 = __attribute__((ext_vector_type(8))) short;
using s16x4  = __attribute__((ext_vector_type(4))) short;
using f32x16 = __attribute__((ext_vector_type(16))) float;
using f32x8  = __attribute__((ext_vector_type(8))) float;
using u32x4  = __attribute__((ext_vector_type(4))) unsigned;
#define KSWZ(row, colB) ((row) * 384 + ((colB) ^ ((((row) >> 1) & 7) << 4)))
#define SBAR() __builtin_amdgcn_sched_barrier(0)
__device__ __forceinline__ int crow(int r, int hi) { return (r & 3) + 8 * (r >> 2) + 4 * hi; }
__device__ __forceinline__ unsigned cvtpk(float lo, float hi) {
  unsigned r; asm volatile("v_cvt_pk_bf16_f32 %0, %1, %2" : "=v"(r) : "v"(lo), "v"(hi)); return r;
}
__device__ __forceinline__ void partialSM(f32x16& p0, f32x16& p1, float& m_reg, float& mn, float& alpha) {
  constexpr float C = SCALE * 1.4426950408889634f;
  float pmax = p0[0]; for (int r = 1; r < 16; ++r) pmax = fmaxf(pmax, p0[r]); for (int r = 0; r < 16; ++r) pmax = fmaxf(pmax, p1[r]);
  { auto rr = __builtin_amdgcn_permlane32_swap(__float_as_uint(pmax), __float_as_uint(pmax), false, false);
    pmax = fmaxf(__uint_as_float(rr[0]), __uint_as_float(rr[1])); }
  if (__builtin_expect(__all(pmax - m_reg <= THR / SCALE), 1)) { mn = m_reg; alpha = 1.f; }
  else { mn = fmaxf(m_reg, pmax); alpha = __builtin_amdgcn_exp2f((m_reg - mn) * C); m_reg = mn; }
  float mnC = -mn * C;
  for (int r = 0; r < 16; ++r) p0[r] = fmaf(p0[r], C, mnC); for (int r = 0; r < 16; ++r) p1[r] = fmaf(p1[r], C, mnC);
  for (int r = 0; r < 16; ++r) p0[r] = __builtin_amdgcn_exp2f(p0[r]);
}
__device__ __forceinline__ void finishSM(f32x16& p0, f32x16& p1, float alpha, float& l_reg, bf16x8& pa0, bf16x8& pa1, bf16x8& pa2, bf16x8& pa3) {
  for (int r = 0; r < 16; ++r) p1[r] = __builtin_amdgcn_exp2f(p1[r]);
  float ps = 0; for (int r = 0; r < 16; ++r) ps += p0[r]; for (int r = 0; r < 16; ++r) ps += p1[r];
  { auto rr = __builtin_amdgcn_permlane32_swap(__float_as_uint(ps), __float_as_uint(ps), false, false);
    ps = __uint_as_float(rr[0]) + __uint_as_float(rr[1]); }
  l_reg = l_reg * alpha + ps;
#define PK4(P, BASE, OUT) do { unsigned a0 = cvtpk(P[BASE + 0], P[BASE + 1]), a1 = cvtpk(P[BASE + 2], P[BASE + 3]);   \
    unsigned b0 = cvtpk(P[BASE + 4], P[BASE + 5]), b1 = cvtpk(P[BASE + 6], P[BASE + 7]);                              \
    auto r0 = __builtin_amdgcn_permlane32_swap(a0, b0, false, false); auto r1 = __builtin_amdgcn_permlane32_swap(a1, b1, false, false); \
    u32x4 w = {r0[0], r1[0], r0[1], r1[1]}; OUT = *reinterpret_cast<bf16x8*>(&w); } while (0)
  PK4(p0, 0, pa0); PK4(p0, 8, pa1); PK4(p1, 0, pa2); PK4(p1, 8, pa3);
#undef PK4
}
__device__ __forceinline__ int v_st(int k, int c) { const int kk = (k & ~0xC) | ((k & 4) << 1) | ((k & 8) >> 1); return ((kk >> 3) * 4 + (c >> 5)) * 512 + ((kk & 7) * 32 + (c & 31)) * 2; }
__device__ __forceinline__ int v_rd_base(int lane) { return ((lane & 3) << 3) | (((lane >> 2) & 3) << 6) | (((lane >> 4) & 1) << 5) | (((lane >> 5) & 1) << 8); }
constexpr int v_rd_off(int d0, int ks, int half) { return d0 * 512 + ks * 4096 + half * 2048; }
template <int OFF> __device__ __forceinline__ s16x4 tr_read(int vb) {
  s16x4 r; asm volatile("ds_read_b64_tr_b16 %0, %1 offset:%2" : "=&v"(r) : "v"(vb), "i"(OFF) : "memory"); return r;
}
template <int D0> __device__ __forceinline__ void pv_one(f32x16& od, int vb, bf16x8 pa0, bf16x8 pa1, bf16x8 pa2, bf16x8 pa3) {
  const s16x4 l0 = tr_read<v_rd_off(D0, 0, 0)>(vb), h0 = tr_read<v_rd_off(D0, 0, 1)>(vb), l1 = tr_read<v_rd_off(D0, 1, 0)>(vb), h1 = tr_read<v_rd_off(D0, 1, 1)>(vb);
  const s16x4 l2 = tr_read<v_rd_off(D0, 2, 0)>(vb), h2 = tr_read<v_rd_off(D0, 2, 1)>(vb), l3 = tr_read<v_rd_off(D0, 3, 0)>(vb), h3 = tr_read<v_rd_off(D0, 3, 1)>(vb);
  asm volatile("s_waitcnt lgkmcnt(0)" ::: "memory"); SBAR();
#define PK(L, H) (bf16x8){L[0], L[1], L[2], L[3], H[0], H[1], H[2], H[3]}
  od = __builtin_amdgcn_mfma_f32_32x32x16_bf16(pa0, PK(l0, h0), od, 0, 0, 0);
  od = __builtin_amdgcn_mfma_f32_32x32x16_bf16(pa1, PK(l1, h1), od, 0, 0, 0);
  od = __builtin_amdgcn_mfma_f32_32x32x16_bf16(pa2, PK(l2, h2), od, 0, 0, 0);
  od = __builtin_amdgcn_mfma_f32_32x32x16_bf16(pa3, PK(l3, h3), od, 0, 0, 0);
#undef PK
}
template <int D0> __device__ __forceinline__ void pv_rd(s16x4 (&f)[8], int vb) {
  f[0] = tr_read<v_rd_off(D0, 0, 0)>(vb); f[1] = tr_read<v_rd_off(D0, 0, 1)>(vb); f[2] = tr_read<v_rd_off(D0, 1, 0)>(vb); f[3] = tr_read<v_rd_off(D0, 1, 1)>(vb);
  f[4] = tr_read<v_rd_off(D0, 2, 0)>(vb); f[5] = tr_read<v_rd_off(D0, 2, 1)>(vb); f[6] = tr_read<v_rd_off(D0, 3, 0)>(vb); f[7] = tr_read<v_rd_off(D0, 3, 1)>(vb);
}
__device__ __forceinline__ void pv_mm(f32x16& od, const s16x4 (&f)[8], bf16x8 pa0, bf16x8 pa1, bf16x8 pa2, bf16x8 pa3) {
#define PK(L, H) (bf16x8){L[0], L[1], L[2], L[3], H[0], H[1], H[2], H[3]}
  od = __builtin_amdgcn_mfma_f32_32x32x16_bf16(pa0, PK(f[0], f[1]), od, 0, 0, 0);
  od = __builtin_amdgcn_mfma_f32_32x32x16_bf16(pa1, PK(f[2], f[3]), od, 0, 0, 0);
  od = __builtin_amdgcn_mfma_f32_32x32x16_bf16(pa2, PK(f[4], f[5]), od, 0, 0, 0);
  od = __builtin_amdgcn_mfma_f32_32x32x16_bf16(pa3, PK(f[6], f[7]), od, 0, 0, 0);
#undef PK
}
#define PV_WAIT(n, f) asm volatile("s_waitcnt lgkmcnt(" #n ")" : "+v"(f[0]), "+v"(f[1]), "+v"(f[2]), "+v"(f[3]), "+v"(f[4]), "+v"(f[5]), "+v"(f[6]), "+v"(f[7]) :: "memory")
__device__ __forceinline__ void pv_d0(f32x16* o, int vb, bf16x8 pa0, bf16x8 pa1, bf16x8 pa2, bf16x8 pa3) {
  s16x4 fa[8], fb[8];
  pv_rd<0>(fa, vb); pv_rd<1>(fb, vb);
  PV_WAIT(8, fa); pv_mm(o[0], fa, pa0, pa1, pa2, pa3);
  pv_rd<2>(fa, vb);
  PV_WAIT(8, fb); pv_mm(o[1], fb, pa0, pa1, pa2, pa3);
  pv_rd<3>(fb, vb);
  PV_WAIT(8, fa); pv_mm(o[2], fa, pa0, pa1, pa2, pa3);
  PV_WAIT(0, fb); pv_mm(o[3], fb, pa0, pa1, pa2, pa3);
}
#undef PV_WAIT
__device__ __forceinline__ void qkt(f32x16& p0, f32x16& p1, const char* Ks, const bf16x8* qr, const bf16x8* qs, const int* kb) {
  p0 = f32x16{}; p1 = f32x16{};
#pragma unroll
  for (int d0 = 0; d0 < 12; ++d0) { const int off = kb[d0 & 3] + (d0 >> 2) * 128;
    bf16x8 b0 = *reinterpret_cast<const bf16x8*>(Ks + off);
    bf16x8 b1 = *reinterpret_cast<const bf16x8*>(Ks + off + 32 * 384);
    const bf16x8 q = d0 < 8 ? qr[d0 < 8 ? d0 : 0] : qs[(d0 - 8) * 64];
    p0 = __builtin_amdgcn_mfma_f32_32x32x16_bf16(b0, q, p0, 0, 0, 0);
    p1 = __builtin_amdgcn_mfma_f32_32x32x16_bf16(b1, q, p1, 0, 0, 0); }
}
__device__ __forceinline__ unsigned short f2bf16(float f) { unsigned u = __builtin_bit_cast(unsigned, f); return (unsigned short)((u + 0x7fffu + ((u >> 16) & 1u)) >> 16); }
__device__ __forceinline__ void attn_unit(const bf16* __restrict__ Qb, const bf16* __restrict__ KN, const bf16* __restrict__ KR,
                                          bf16* __restrict__ Ob, int lat0, int nlat, int ctx0, int seq, char* lds,
                                          const float* __restrict__ qn_g, const float* __restrict__ qr_g, const float* __restrict__ rope, int npos0) {
  const int tid = tidx(), wid = tid >> 6, lane = tid & 63, r32 = lane & 31, hi = lane >> 5;
  char* V_lds = lds; char* K_lds = lds + 3 * SHM_V;
  float* ws = (float*)(lds + 3 * SHM_V + 3 * SHM_K) + wid * 64; float* li_l = ws; float* al_l = ws + 32;
  float m_reg = -1e30f, l_reg = 0; f32x16 o[4] = {}; bf16x8 qr[8];
  bf16x8* qs = (bf16x8*)(lds + QS_OFF) + wid * 4 * 64 + lane;
  const bf16* Qw = Qb + (long)(wid * QBLK + r32) * LDQ + hi * 8;
  {
    bf16x8 raw[12];
#pragma unroll
    for (int d0 = 0; d0 < 12; ++d0) raw[d0] = *reinterpret_cast<const bf16x8*>(Qw + d0 * 16);
    float ssn = 0.f, ssr = 0.f;
#pragma unroll
    for (int d0 = 0; d0 < 12; ++d0)
#pragma unroll
      for (int e = 0; e < 8; ++e) { const float v = __builtin_bit_cast(float, ((unsigned)(unsigned short)raw[d0][e]) << 16); if (d0 < 8) ssn += v * v; else ssr += v * v; }
    ssn += __shfl_xor(ssn, 32); ssr += __shfl_xor(ssr, 32);
    const float rsn = 1.0f / sqrtf(ssn * (1.0f / 128) + 1e-6f), rsr = 1.0f / sqrtf(ssr * (1.0f / 64) + 1e-6f);
#pragma unroll
    for (int d0 = 0; d0 < 8; ++d0) { u32x4 w;
#pragma unroll
      for (int e2 = 0; e2 < 4; ++e2) { const int d = d0 * 16 + hi * 8 + 2 * e2;
        const float v0 = __builtin_bit_cast(float, ((unsigned)(unsigned short)raw[d0][2 * e2]) << 16) * rsn * qn_g[d], v1 = __builtin_bit_cast(float, ((unsigned)(unsigned short)raw[d0][2 * e2 + 1]) << 16) * rsn * qn_g[d + 1];
        w[e2] = cvtpk(v0, v1); }
      qr[d0] = *reinterpret_cast<bf16x8*>(&w); }
    const int npos = npos0 < 0 ? -1 : npos0 + wid * QBLK + r32;
#pragma unroll
    for (int a = 0; a < 2; ++a) { u32x4 w0, w1; const int pos = a ? (npos & 63) : (npos >> 6);
#pragma unroll
      for (int e2 = 0; e2 < 4; ++e2) { float o0[2], o1[2];
#pragma unroll
        for (int t = 0; t < 2; ++t) { const int e = 2 * e2 + t, f = hi * 8 + e;
          const float x0 = __builtin_bit_cast(float, ((unsigned)(unsigned short)raw[8 + 2 * a][e]) << 16) * rsr * qr_g[a * 32 + f];
          const float x1 = __builtin_bit_cast(float, ((unsigned)(unsigned short)raw[9 + 2 * a][e]) << 16) * rsr * qr_g[a * 32 + 16 + f];
          float c = 1.f, sn = 0.f; if (npos >= 0) { c = rope[(pos * 16 + f) * 2]; sn = rope[(pos * 16 + f) * 2 + 1]; }
          o0[t] = x0 * c - x1 * sn; o1[t] = x1 * c + x0 * sn; }
        w0[e2] = cvtpk(o0[0], o0[1]); w1[e2] = cvtpk(o1[0], o1[1]); }
      qs[(2 * a) * 64] = *reinterpret_cast<bf16x8*>(&w0); qs[(2 * a + 1) * 64] = *reinterpret_cast<bf16x8*>(&w1); }
  }
  int kb[4];
#pragma unroll
  for (int j = 0; j < 4; ++j) kb[j] = r32 * 384 + ((j * 32 + hi * 16) ^ (((r32 >> 1) & 7) << 4));
  const int sr = tid >> 4, sc = (tid & 15) * 8, vst0 = v_st(sr, sc), vst1 = v_st(32 + sr, sc);
  const int knd0 = KSWZ(sr, sc * 2), knd1 = knd0 + 32 * 384, krd = KSWZ(tid >> 3, (16 + (tid & 7)) * 16);
  const int vb0 = (int)(uintptr_t)V_lds + v_rd_base(lane);
  bf16x8 vs0, vs1, ks0, ks1, ks2;
#define KROW(k0) (((k0) < nlat) ? lat0 + (k0) : ctx0 + (k0) - nlat)
#define SLOAD(k0) do { const long rb = KROW(k0); const bf16* pn = KN + (rb + sr) * LDKN + sc; \
    ks0 = *reinterpret_cast<const bf16x8*>(pn); ks1 = *reinterpret_cast<const bf16x8*>(pn + 32 * LDKN); vs0 = *reinterpret_cast<const bf16x8*>(pn + 128); vs1 = *reinterpret_cast<const bf16x8*>(pn + 32 * LDKN + 128); \
    ks2 = *reinterpret_cast<const bf16x8*>(KR + rb * LDKR + tid * 8); } while (0)
#define SWRITE(b) do { *(bf16x8*)(V_lds + (b) * SHM_V + vst0) = vs0; *(bf16x8*)(V_lds + (b) * SHM_V + vst1) = vs1; \
    *(bf16x8*)(K_lds + (b) * SHM_K + knd0) = ks0; *(bf16x8*)(K_lds + (b) * SHM_K + knd1) = ks1; *(bf16x8*)(K_lds + (b) * SHM_K + krd) = ks2; } while (0)
#define SWAIT() asm volatile("s_waitcnt vmcnt(0)" ::: "memory")
#define RESC(a) do { if (__any((a) < 1.f)) { if (hi == 0) al_l[r32] = (a); asm volatile("s_waitcnt lgkmcnt(0)" ::: "memory"); \
    for (int d = 0; d < 4; ++d) for (int r = 0; r < 16; ++r) o[d][r] *= al_l[crow(r, hi)]; } } while (0)
  f32x16 pA0, pA1, pB0, pB1; float mnA, mnB, alA, alB; bf16x8 pa0, pa1, pa2, pa3; const int NT = seq / KVBLK;
  SLOAD(0); SWAIT(); SWRITE(0); __syncthreads();
  qkt(pA0, pA1, K_lds, qr, qs, kb); partialSM(pA0, pA1, m_reg, mnA, alA);
  SLOAD(KVBLK); SWAIT(); SWRITE(1); __syncthreads();
  int rp = 0, rc = 1, rn = 2;
  for (int j = 1; j + 1 < NT; j += 2) {
    SBAR(); qkt(pB0, pB1, K_lds + rc * SHM_K, qr, qs, kb);
    finishSM(pA0, pA1, alA, l_reg, pa0, pa1, pa2, pa3); SBAR();
    SLOAD((j + 1) * KVBLK); SBAR();
    pv_d0(o, vb0 + rp * SHM_V, pa0, pa1, pa2, pa3); partialSM(pB0, pB1, m_reg, mnB, alB);
    SWAIT(); SWRITE(rn);
    RESC(alB); __syncthreads();
    { const int t = rp; rp = rc; rc = rn; rn = t; }
    SBAR(); qkt(pA0, pA1, K_lds + rc * SHM_K, qr, qs, kb);
    finishSM(pB0, pB1, alB, l_reg, pa0, pa1, pa2, pa3); SBAR();
    SLOAD((j + 2) * KVBLK); SBAR();
    pv_d0(o, vb0 + rp * SHM_V, pa0, pa1, pa2, pa3); partialSM(pA0, pA1, m_reg, mnA, alA);
    SWAIT(); SWRITE(rn);
    RESC(alA); __syncthreads();
    { const int t = rp; rp = rc; rc = rn; rn = t; }
  }
  SBAR(); qkt(pB0, pB1, K_lds + rc * SHM_K, qr, qs, kb);
  finishSM(pA0, pA1, alA, l_reg, pa0, pa1, pa2, pa3); SBAR();
  pv_d0(o, vb0 + rp * SHM_V, pa0, pa1, pa2, pa3); partialSM(pB0, pB1, m_reg, mnB, alB);
  RESC(alB);
  finishSM(pB0, pB1, alB, l_reg, pa0, pa1, pa2, pa3); SBAR();
  pv_d0(o, vb0 + rc * SHM_V, pa0, pa1, pa2, pa3);
  if (hi == 0) li_l[r32] = l_reg; asm volatile("s_waitcnt lgkmcnt(0)" ::: "memory");
  float rli[16];
#pragma unroll
  for (int r = 0; r < 16; ++r) rli[r] = __builtin_amdgcn_rcpf(li_l[crow(r, hi)]);
  bf16* Ow = Ob + (long)(wid * QBLK) * LDO;
#pragma unroll
  for (int r = 0; r < 16; ++r) { const int orow = crow(r, hi);
#pragma unroll
    for (int d0 = 0; d0 < 4; ++d0) Ow[(long)orow * LDO + d0 * 32 + r32] = f2bf16(o[d0][r] * rli[r]); }
#undef KROW
#undef SLOAD
#undef SWRITE
#undef SWAIT
#undef RESC
}
#undef SBAR
#undef KSWZ
}
#define LAS __attribute__((address_space(3)))
typedef unsigned short bf16;
typedef unsigned v4u __attribute__((ext_vector_type(4)));
typedef unsigned v2u __attribute__((ext_vector_type(2)));
typedef float f32x4 __attribute__((ext_vector_type(4)));
constexpr size_t MiB = 1u << 20;
constexpr size_t WS_MOD = 0, WS_ROPE = 1 * MiB, WS_XC = 2 * MiB, WS_W = 6 * MiB, WS_H = 96 * MiB, WS_Y = 162 * MiB, WS_QL = 261 * MiB, WS_KVL = 278 * MiB,
                 WS_Q = 287 * MiB, WS_KV = 337 * MiB, WS_KR = 403 * MiB, WS_MIX = 408 * MiB, WS_EDGE = 408 * MiB, WS_HID = 162 * MiB, WS_END = 506 * MiB;
constexpr size_t WO_IN = 0, WO_Q = WO_IN + (size_t)INP * DM, WO_KV = WO_Q + (size_t)768 * QRK, WO_O = WO_KV + (size_t)1024 * KVRK, WO_UP = WO_O + (size_t)DM * DM,
                 WO_DN = WO_UP + (size_t)2 * DFF * DM, W_LAYER = WO_DN + (size_t)DM * DFF;
static_assert(WS_W + W_LAYER * 2 * DEPTH <= WS_H && WS_H + (size_t)TT * DM * 2 <= WS_Y && WS_Y + (size_t)TT * INP * 2 <= WS_QL && WS_QL + (size_t)TT * QRK * 2 <= WS_KVL &&
              WS_KVL + (size_t)TT * KVRK * 2 <= WS_Q && WS_Q + (size_t)TT * 768 * 2 <= WS_KV && WS_KV + (size_t)TT * 1024 * 2 <= WS_KR && WS_KR + (size_t)TT * 64 * 2 <= WS_MIX &&
              WS_MIX + (size_t)TT * DM * 2 <= 474 * MiB && WS_EDGE + (size_t)3 * (TT / 64) * 2 * DFF * 4 <= 474 * MiB && WS_HID + (size_t)TT * DFF * 2 <= WS_KR, "d_ws map");
constexpr size_t WS_PART_WO = 344 * MiB;
constexpr size_t WS_PART_DN = 408 * MiB;
constexpr size_t WS_X1A = 376 * MiB, WS_X1B = 474 * MiB;
constexpr int X1_SPLIT = 16384;
static_assert(WS_PART_WO >= WS_HID + (size_t)TT * DFF * 2 && WS_PART_WO + (size_t)8 * TCTX * DM * 4 <= WS_X1A && WS_X1A + (size_t)X1_SPLIT * DM * 2 <= WS_MIX &&
              WS_PART_DN + (size_t)11 * TCTX * DM * 4 <= 474 * MiB && WS_X1B + (size_t)(TLAT - X1_SPLIT) * DM * 2 <= WS_END, "slabs and x1 map");
constexpr size_t EDGE_N = (size_t)(TT / 64) * 2 * DFF;
constexpr int LDS_BYTES = 163840, LDS_ST_OFF = LDS_BYTES - 64;
constexpr size_t WS_BAR = WS_ROPE + 512 * 1024;
constexpr int NPH = 1 + 9 * DEPTH;
static_assert(att::ATTN_LDS <= LDS_ST_OFF, "attention LDS map below the barrier words");

__device__ __forceinline__ unsigned f2bf(float f) { unsigned u = __builtin_bit_cast(unsigned, f); return (u + 0x7fffu + ((u >> 16) & 1u)) >> 16; }
__device__ __forceinline__ unsigned pk2(float lo, float hi) { typedef float f32x2_c __attribute__((ext_vector_type(2))); typedef __bf16 bf16x2_c __attribute__((ext_vector_type(2)));
    const f32x2_c v = {lo, hi}; const bf16x2_c b = __builtin_convertvector(v, bf16x2_c); return __builtin_bit_cast(unsigned, b); }
__device__ __forceinline__ float bflo(unsigned w) { return __builtin_bit_cast(float, w << 16); }
__device__ __forceinline__ float bfhi(unsigned w) { return __builtin_bit_cast(float, w & 0xffff0000u); }
__device__ __forceinline__ float wave_sum(float v) {
    v += __builtin_bit_cast(float, __builtin_amdgcn_update_dpp(0, __builtin_bit_cast(int, v), 0xB1, 0xF, 0xF, true));
    v += __builtin_bit_cast(float, __builtin_amdgcn_update_dpp(0, __builtin_bit_cast(int, v), 0x4E, 0xF, 0xF, true));
    v += __builtin_bit_cast(float, __builtin_amdgcn_update_dpp(0, __builtin_bit_cast(int, v), 0x141, 0xF, 0xF, true));
    v += __builtin_bit_cast(float, __builtin_amdgcn_update_dpp(0, __builtin_bit_cast(int, v), 0x140, 0xF, 0xF, true));
    const float r0 = __builtin_bit_cast(float, __builtin_amdgcn_readlane(__builtin_bit_cast(int, v), 0)), r1 = __builtin_bit_cast(float, __builtin_amdgcn_readlane(__builtin_bit_cast(int, v), 16));
    const float r2 = __builtin_bit_cast(float, __builtin_amdgcn_readlane(__builtin_bit_cast(int, v), 32)), r3 = __builtin_bit_cast(float, __builtin_amdgcn_readlane(__builtin_bit_cast(int, v), 48));
    v = (r0 + r1) + (r2 + r3);
    return v;
}
#define LDS_WAIT() asm volatile("s_waitcnt lgkmcnt(0)" ::: "memory")

#define XB_TMO      128
#define XB_XCNT(j)  (256  + 64 * (j))
#define XB_XSUB(j)  (1280 + 64 * (j))
#define XB_XGEN(j)  (2304 + 64 * (j))
#define XB_TOP      3328
#define XB_TOPGEN   3392
#define XCD_BAR_WORDS 3456
#define XB_SPIN_CAP (1u << 18)

__device__ __forceinline__ unsigned xb_ld(unsigned* p)              { return __hip_atomic_load(p, __ATOMIC_RELAXED, __HIP_MEMORY_SCOPE_AGENT); }
__device__ __forceinline__ unsigned xb_add(unsigned* p, unsigned v) { return __hip_atomic_fetch_add(p, v, __ATOMIC_RELAXED, __HIP_MEMORY_SCOPE_AGENT); }
__device__ __forceinline__ unsigned xb_xcc_id() { return (unsigned)__builtin_amdgcn_s_getreg((3 << 11) | 20) & 0xFu; }
#define XB_SPIN(cond, bar) do { unsigned _sp = 0; while (cond) { __builtin_amdgcn_s_sleep(1); \
    if ((++_sp & 255u) == 0u) { if (xb_ld(&(bar)[XB_TMO])) break; if (_sp > XB_SPIN_CAP) { atomicAdd(&(bar)[XB_TMO], 1u); break; } } } } while (0)

struct XcdBarrier {
    unsigned* bar; unsigned x;
    volatile LAS unsigned* st;
};

__device__ __forceinline__ XcdBarrier xcd_barrier_post(unsigned* bar, volatile LAS unsigned* st) {
    XcdBarrier b; b.bar = bar; b.x = xb_xcc_id(); b.st = st;
    if (tidx() == 0) (void)xb_add(&bar[XB_XCNT(b.x)], 1u);
    return b;
}
__device__ __forceinline__ void xcd_barrier_complete(unsigned* bar, unsigned x, unsigned& nloc, unsigned& nx) {
    const unsigned G = gridDim.x * gridDim.y * gridDim.z;
    unsigned sum, cnt, mine, sp = 0u;
    for (;;) {
        sum = 0u; cnt = 0u; mine = 0u;
#pragma unroll
        for (unsigned j = 0; j < 16; ++j) { const unsigned c = xb_ld(&bar[XB_XCNT(j)]); sum += c; cnt += (c > 0u) ? 1u : 0u; mine = (j == x) ? c : mine; }
        if (sum == G) break;
        __builtin_amdgcn_s_sleep(1);
        if ((++sp & 255u) == 0u) { if (xb_ld(&bar[XB_TMO])) break; if (sp > XB_SPIN_CAP) { atomicAdd(&bar[XB_TMO], 1u); break; } }
    }
    nloc = mine > 0u ? mine : 1u; nx = cnt > 0u ? cnt : 1u;
}

__device__ __forceinline__ void xcd_barrier(const XcdBarrier& b) {
    asm volatile("s_waitcnt vmcnt(0)" ::: "memory");
    __syncthreads();
    if (tidx() == 0) {
        unsigned* bar = b.bar;
        __builtin_amdgcn_s_waitcnt(0);
        unsigned nloc = b.st[0], nx = b.st[1];
        if (nloc == 0u) { xcd_barrier_complete(bar, b.x, nloc, nx); b.st[0] = nloc; b.st[1] = nx; }
        const unsigned old = xb_add(&bar[XB_XSUB(b.x)], 1u);
        const unsigned gen = old / nloc;
        if (old + 1u == (gen + 1u) * nloc) {
            __builtin_amdgcn_fence(__ATOMIC_RELEASE, "agent");
            asm volatile("s_waitcnt vmcnt(0)" ::: "memory");
            const unsigned og = xb_add(&bar[XB_TOP], 1u);
            const unsigned tg = og / nx;
            if (og + 1u == (tg + 1u) * nx) xb_add(&bar[XB_TOPGEN], 1u);
            else XB_SPIN(xb_ld(&bar[XB_TOPGEN]) == tg, bar);
            __builtin_amdgcn_fence(__ATOMIC_ACQUIRE, "agent");
            xb_add(&bar[XB_XGEN(b.x)], 1u);
            asm volatile("s_waitcnt vmcnt(0)" ::: "memory");
        } else {
            XB_SPIN(xb_ld(&bar[XB_XGEN(b.x)]) == gen, bar);
            __builtin_amdgcn_fence(__ATOMIC_ACQUIRE, "agent");
            asm volatile("s_waitcnt vmcnt(0)" ::: "memory");
        }
    }
    __syncthreads();
}

struct Params { const float* in[24]; float* out; unsigned char* ws; int ph_lo, ph_hi; };
typedef const Params __attribute__((address_space(4))) CParams;
namespace pg8 {
__device__ __forceinline__ unsigned f2bf(float f) { unsigned u = __builtin_bit_cast(unsigned, f); return (u + 0x7fffu + ((u >> 16) & 1u)) >> 16; }
__device__ __forceinline__ unsigned pk2(float lo, float hi) { typedef float f32x2_c __attribute__((ext_vector_type(2))); typedef __bf16 bf16x2_c __attribute__((ext_vector_type(2)));
    const f32x2_c v = {lo, hi}; const bf16x2_c b = __builtin_convertvector(v, bf16x2_c); return __builtin_bit_cast(unsigned, b); }
struct EpiStore {
    static constexpr bool PERM = true, AFTER_DRAIN = false;
    bf16_t* O; int ldc;
    __device__ __forceinline__ void operator()(const f32x4 (&acc)[2][2][4][2], const Unit& u, int wr, int wc, int fr, int fq) const {
        const int row0 = u.pm * BM + wr * 64 + fr, col0 = u.pn * BM + wc * 32 + 8 * fq;
#pragma unroll
        for (int ai = 0; ai < 2; ++ai)
#pragma unroll
            for (int m = 0; m < 4; ++m) { bf16_t* rowp = O + (size_t)(row0 + ai * HALF + m * 16) * ldc + col0;
#pragma unroll
                for (int bj = 0; bj < 2; ++bj) { const f32x4 v0 = acc[ai][bj][m][0], v1 = acc[ai][bj][m][1];
                    u32x4 w; w.x = pk2(v0[0], v0[1]); w.y = pk2(v0[2], v0[3]); w.z = pk2(v1[0], v1[1]); w.w = pk2(v1[2], v1[3]);
                    *(u32x4*)(rowp + bj * HALF) = w; } }
    }
};
struct EpiKv {
    static constexpr bool PERM = true, AFTER_DRAIN = false;
    bf16_t* O; const float* kn_g; __attribute__((address_space(3))) float* X;
    __device__ __forceinline__ void operator()(const f32x4 (&acc)[2][2][4][2], const Unit& u, int wr, int wc, int fr, int fq) const {
        const int row0 = u.pm * BM + wr * 64 + fr, col0 = u.pn * BM + wc * 32 + 8 * fq;
        float ss[2][4];
#pragma unroll
        for (int ai = 0; ai < 2; ++ai)
#pragma unroll
            for (int m = 0; m < 4; ++m) { const f32x4 a = acc[ai][0][m][0], b = acc[ai][0][m][1];
                float s = ((a[0] * a[0] + a[1] * a[1]) + (a[2] * a[2] + a[3] * a[3])) + ((b[0] * b[0] + b[1] * b[1]) + (b[2] * b[2] + b[3] * b[3]));
                s += __shfl_xor(s, 16); s += __shfl_xor(s, 32);
                ss[ai][m] = s; }
        if (fq == 0) {
#pragma unroll
            for (int ai = 0; ai < 2; ++ai)
#pragma unroll
                for (int m = 0; m < 4; ++m) X[(ai * HALF + wr * 64 + m * 16 + fr) * 4 + wc] = ss[ai][m]; }
        asm volatile("s_waitcnt lgkmcnt(0)" ::: "memory"); __builtin_amdgcn_s_barrier(); asm volatile("" ::: "memory");
        const f32x4 g0 = *(const f32x4*)(kn_g + wc * 32 + 8 * fq), g1 = *(const f32x4*)(kn_g + wc * 32 + 8 * fq + 4);
#pragma unroll
        for (int ai = 0; ai < 2; ++ai)
#pragma unroll
            for (int m = 0; m < 4; ++m) { bf16_t* rowp = O + (size_t)(row0 + ai * HALF + m * 16) * 1024 + col0;
                const f32x4 xp = *(const __attribute__((address_space(3))) f32x4*)(X + (ai * HALF + wr * 64 + m * 16 + fr) * 4);
                const float rs = 1.0f / sqrtf(((xp[0] + xp[1]) + (xp[2] + xp[3])) * (1.0f / 128) + EPSN);
                { const f32x4 v0 = acc[ai][0][m][0] * rs * g0, v1 = acc[ai][0][m][1] * rs * g1;
                  u32x4 w; w.x = pk2(v0[0], v0[1]); w.y = pk2(v0[2], v0[3]); w.z = pk2(v1[0], v1[1]); w.w = pk2(v1[2], v1[3]); *(u32x4*)(rowp) = w; }
                { const f32x4 v0 = acc[ai][1][m][0], v1 = acc[ai][1][m][1];
                  u32x4 w; w.x = pk2(v0[0], v0[1]); w.y = pk2(v0[2], v0[3]); w.z = pk2(v1[0], v1[1]); w.w = pk2(v1[2], v1[3]); *(u32x4*)(rowp + HALF) = w; } }
    }
};
struct EpiIn {
    static constexpr bool PERM = true, AFTER_DRAIN = false;
    unsigned char* ws; const float* qc_g; const float* kvc_g; const float* kr_g; __attribute__((address_space(3))) float* X;
    __device__ __forceinline__ void operator()(const f32x4 (&acc)[2][2][4][2], const Unit& u, int wr, int wc, int fr, int fq) const {
        bf16_t* Y = (bf16_t*)(ws + WS_Y);
        const int row0 = u.pm * BM + wr * 64 + fr;
        if (u.pn >= 2) { EpiStore E{Y, INP}; E(acc, u, wr, wc, fr, fq); return; }
#pragma unroll
        for (int ai = 0; ai < 2; ++ai)
#pragma unroll
            for (int m = 0; m < 4; ++m) {
                float s[2];
#pragma unroll
                for (int bj = 0; bj < 2; ++bj) { const f32x4 a = acc[ai][bj][m][0], b = acc[ai][bj][m][1];
                    float t = ((a[0] * a[0] + a[1] * a[1]) + (a[2] * a[2] + a[3] * a[3])) + ((b[0] * b[0] + b[1] * b[1]) + (b[2] * b[2] + b[3] * b[3]));
                    t += __shfl_xor(t, 16); t += __shfl_xor(t, 32); s[bj] = t; }
                if (fq == 0) { const int xr = (ai * HALF + wr * 64 + m * 16 + fr) * 8; X[xr + wc] = s[0]; X[xr + 4 + wc] = s[1]; } }
        asm volatile("s_waitcnt lgkmcnt(0)" ::: "memory"); __builtin_amdgcn_s_barrier(); asm volatile("" ::: "memory");
        const int c8 = wc * 32 + 8 * fq;
        if (u.pn == 0) {
            bf16_t* QLp = (bf16_t*)(ws + WS_QL);
            f32x4 g[2][2];
#pragma unroll
            for (int bj = 0; bj < 2; ++bj) { g[bj][0] = *(const f32x4*)(qc_g + bj * HALF + c8); g[bj][1] = *(const f32x4*)(qc_g + bj * HALF + c8 + 4); }
#pragma unroll
            for (int ai = 0; ai < 2; ++ai)
#pragma unroll
                for (int m = 0; m < 4; ++m) { const int lr = ai * HALF + wr * 64 + m * 16 + fr;
                    const f32x4 xa = *(const __attribute__((address_space(3))) f32x4*)(X + lr * 8), xb = *(const __attribute__((address_space(3))) f32x4*)(X + lr * 8 + 4);
                    const float rs = 1.0f / sqrtf((((xa[0] + xa[1]) + (xa[2] + xa[3])) + ((xb[0] + xb[1]) + (xb[2] + xb[3]))) * (1.0f / QRK) + EPSN);
                    bf16_t* rowp = QLp + (size_t)(row0 + ai * HALF + m * 16) * QRK + c8;
#pragma unroll
                    for (int bj = 0; bj < 2; ++bj) { const f32x4 v0 = acc[ai][bj][m][0] * rs * g[bj][0], v1 = acc[ai][bj][m][1] * rs * g[bj][1];
                        u32x4 w; w.x = pk2(v0[0], v0[1]); w.y = pk2(v0[2], v0[3]); w.z = pk2(v1[0], v1[1]); w.w = pk2(v1[2], v1[3]); *(u32x4*)(rowp + bj * HALF) = w; } }
        } else {
            bf16_t* KVLp = (bf16_t*)(ws + WS_KVL); bf16_t* KRp = (bf16_t*)(ws + WS_KR); const float* rope = (const float*)(ws + WS_ROPE);
            const f32x4 gk0 = *(const f32x4*)(kvc_g + c8), gk1 = *(const f32x4*)(kvc_g + c8 + 4);
            const bool lat = u.pm * BM < TLAT;
#pragma unroll
            for (int ai = 0; ai < 2; ++ai)
#pragma unroll
                for (int m = 0; m < 4; ++m) { const int lr = ai * HALF + wr * 64 + m * 16 + fr; const int row = row0 + ai * HALF + m * 16;
                    const f32x4 xa = *(const __attribute__((address_space(3))) f32x4*)(X + lr * 8), xb = *(const __attribute__((address_space(3))) f32x4*)(X + lr * 8 + 4);
                    { const float rs = 1.0f / sqrtf(((xa[0] + xa[1]) + (xa[2] + xa[3])) * (1.0f / KVRK) + EPSN);
                      const f32x4 v0 = acc[ai][0][m][0] * rs * gk0, v1 = acc[ai][0][m][1] * rs * gk1;
                      u32x4 w; w.x = pk2(v0[0], v0[1]); w.y = pk2(v0[2], v0[3]); w.z = pk2(v1[0], v1[1]); w.w = pk2(v1[2], v1[3]); *(u32x4*)(KVLp + (size_t)row * KVRK + c8) = w; }
                    if (wc < 2) {
                        const float rs = 1.0f / sqrtf((xb[0] + xb[1]) * (1.0f / 64) + EPSN);
                        const f32x4 gr0 = *(const f32x4*)(kr_g + c8), gr1 = *(const f32x4*)(kr_g + c8 + 4);
                        f32x4 v0 = acc[ai][1][m][0] * rs * gr0, v1 = acc[ai][1][m][1] * rs * gr1;
                        f32x4 p0, p1;
#pragma unroll
                        for (int e = 0; e < 4; ++e) { p0[e] = __shfl_xor(v0[e], 32); p1[e] = __shfl_xor(v1[e], 32); }
                        if (lat) { const int n = row & (SEQ - 1); const int pos = wc ? (n & 63) : (n >> 6); const float* rt = rope + (size_t)(pos * 16 + (fq & 1) * 8) * 2; const float sg = (fq >> 1) ? 1.f : -1.f;
                            const f32x4 t0 = *(const f32x4*)(rt), t1 = *(const f32x4*)(rt + 4), t2 = *(const f32x4*)(rt + 8), t3 = *(const f32x4*)(rt + 12);
                            v0 = (f32x4){v0[0] * t0[0] + sg * p0[0] * t0[1], v0[1] * t0[2] + sg * p0[1] * t0[3], v0[2] * t1[0] + sg * p0[2] * t1[1], v0[3] * t1[2] + sg * p0[3] * t1[3]};
                            v1 = (f32x4){v1[0] * t2[0] + sg * p1[0] * t2[1], v1[1] * t2[2] + sg * p1[1] * t2[3], v1[2] * t3[0] + sg * p1[2] * t3[1], v1[3] * t3[2] + sg * p1[3] * t3[3]}; }
                        u32x4 w; w.x = pk2(v0[0], v0[1]); w.y = pk2(v0[2], v0[3]); w.z = pk2(v1[0], v1[1]); w.w = pk2(v1[2], v1[3]); *(u32x4*)(KRp + (size_t)row * 64 + c8) = w;
                    } else {
                        const f32x4 v0 = acc[ai][1][m][0], v1 = acc[ai][1][m][1];
                        u32x4 w; w.x = pk2(v0[0], v0[1]); w.y = pk2(v0[2], v0[3]); w.z = pk2(v1[0], v1[1]); w.w = pk2(v1[2], v1[3]); *(u32x4*)(Y + (size_t)row * INP + 384 + c8) = w; } }
        }
    }
};
struct EpiResid {
    static constexpr bool PERM = true, AFTER_DRAIN = false;
    const float* xin_lat; const float* xin_ctx; float* out_lat; float* out_ctx; const float* modL; int gate_chunk;
    bf16_t* x1a; bf16_t* x1b; int flags;
    __device__ __forceinline__ void operator()(const f32x4 (&acc)[2][2][4][2], const Unit& u, int wr, int wc, int fr, int fq) const {
        const int rowt = u.pm * BM; const bool lat = rowt < TLAT;
        const int j = lat ? rowt / SEQ : 4;
        const float* gate = modL + j * 6144 + gate_chunk * 1024;
        const float* xin = lat ? xin_lat + (size_t)rowt * DM : xin_ctx + (size_t)(rowt - TLAT) * DM;
        float* xo = lat ? out_lat + (size_t)rowt * DM : out_ctx + (size_t)(rowt - TLAT) * DM;
        const int col0 = u.pn * BM + wc * 32 + 8 * fq;
        typedef unsigned u32x2 __attribute__((ext_vector_type(2)));
        bf16_t* x1p = rowt < X1_SPLIT ? x1a + (size_t)rowt * DM : x1b + (size_t)(rowt - X1_SPLIT) * DM;
        f32x4 gv[2][2];
#pragma unroll
        for (int bj = 0; bj < 2; ++bj)
#pragma unroll
            for (int n = 0; n < 2; ++n) gv[bj][n] = *(const f32x4*)(gate + col0 + bj * HALF + 4 * n);
        f32x4 xa[2][2][2], xb[2][2][2];
#define RES_LOAD(dst, p) do { _Pragma("unroll") for (int g_ = 0; g_ < 2; ++g_) { const int gi_ = (p) * 2 + g_, ai_ = gi_ >> 2, m_ = gi_ & 3; const size_t off_ = (size_t)(wr * 64 + fr + ai_ * HALF + m_ * 16) * DM + col0; \
            _Pragma("unroll") for (int bj = 0; bj < 2; ++bj) _Pragma("unroll") for (int n = 0; n < 2; ++n) { if (flags & 1) { const u32x2 w_ = *(const u32x2*)(x1p + off_ + bj * HALF + 4 * n); dst[g_][bj][n] = (f32x4){__builtin_bit_cast(float, w_.x << 16), __builtin_bit_cast(float, w_.x & 0xffff0000u), __builtin_bit_cast(float, w_.y << 16), __builtin_bit_cast(float, w_.y & 0xffff0000u)}; } \
              else dst[g_][bj][n] = *(const f32x4*)(xin + off_ + bj * HALF + 4 * n); } } } while (0)
#define RES_STORE(src, p) do { _Pragma("unroll") for (int g_ = 0; g_ < 2; ++g_) { const int gi_ = (p) * 2 + g_, ai_ = gi_ >> 2, m_ = gi_ & 3; const size_t off_ = (size_t)(wr * 64 + fr + ai_ * HALF + m_ * 16) * DM + col0; \
            _Pragma("unroll") for (int bj = 0; bj < 2; ++bj) _Pragma("unroll") for (int n = 0; n < 2; ++n) { const f32x4 r_ = src[g_][bj][n] + gv[bj][n] * acc[ai_][bj][m_][n]; \
              if (flags & 2) { u32x2 w_; w_.x = pk2(r_.x, r_.y); w_.y = pk2(r_.z, r_.w); *(u32x2*)(x1p + off_ + bj * HALF + 4 * n) = w_; } else *(f32x4*)(xo + off_ + bj * HALF + 4 * n) = r_; } } } while (0)
        RES_LOAD(xa, 0);
        RES_LOAD(xb, 1); RES_STORE(xa, 0);
        RES_LOAD(xa, 2); RES_STORE(xb, 1);
        RES_LOAD(xb, 3); RES_STORE(xa, 2);
        RES_STORE(xb, 3);
#undef RES_LOAD
#undef RES_STORE
    }
};
struct EpiFfUp {
    static constexpr bool PERM = true, AFTER_DRAIN = false;
    bf16_t* HID; const float* cw; float* GE; float* PE; float* UE;
    __device__ __forceinline__ void operator()(const f32x4 (&acc)[2][2][4][2], const Unit& u, int wr, int wc, int fr, int fq) const {
        const int ch0 = u.pn * HALF + wc * 32 + 8 * fq;
        f32x4 w0[2], w1[2], w2[2];
#pragma unroll
        for (int n = 0; n < 2; ++n) { w0[n] = *(const f32x4*)(cw + ch0 + 4 * n); w1[n] = *(const f32x4*)(cw + DFF + ch0 + 4 * n); w2[n] = *(const f32x4*)(cw + 2 * DFF + ch0 + 4 * n); }
#pragma unroll
        for (int ai = 0; ai < 2; ++ai) {
            const int blk = u.pm * 4 + ai * 2 + wr; const int rowb = u.pm * BM + ai * HALF + wr * 64;
#pragma unroll
            for (int m = 0; m < 4; ++m) {
                float hv[8], cv[8];
#pragma unroll
                for (int n = 0; n < 2; ++n)
#pragma unroll
                    for (int e = 0; e < 4; ++e) {
                        const float g = acc[ai][0][m][n][e];
                        const float gprev = (m > 0) ? acc[ai][0][m > 0 ? m - 1 : 0][n][e] : 0.f;
                        const float gnext = (m < 3) ? acc[ai][0][m < 3 ? m + 1 : 3][n][e] : 0.f;
                        const float up = __builtin_bit_cast(float, __builtin_amdgcn_update_dpp(0, __builtin_bit_cast(int, (fr == 15) ? gprev : g), 0x121, 0xF, 0xF, true));
                        const float dn = __builtin_bit_cast(float, __builtin_amdgcn_update_dpp(0, __builtin_bit_cast(int, (fr == 0) ? gnext : g), 0x12F, 0xF, 0xF, true));
                        const float conv = w0[n][e] * up + w1[n][e] * g + w2[n][e] * dn;
                        cv[4 * n + e] = conv;
                        hv[4 * n + e] = conv * __builtin_amdgcn_rcpf(1.f + __expf(-conv)) * acc[ai][1][m][n][e];
                    }
                u32x4 w; w.x = pk2(hv[0], hv[1]); w.y = pk2(hv[2], hv[3]); w.z = pk2(hv[4], hv[5]); w.w = pk2(hv[6], hv[7]);
                *(u32x4*)(HID + (size_t)(rowb + m * 16 + fr) * DFF + ch0) = w;
                if ((m == 0 && fr == 0) || (m == 3 && fr == 15)) {
                    const size_t eo = ((size_t)blk * 2 + (m == 0 ? 0 : 1)) * DFF + ch0;
#pragma unroll
                    for (int n = 0; n < 2; ++n) { *(f32x4*)(GE + eo + 4 * n) = acc[ai][0][m][n]; *(f32x4*)(UE + eo + 4 * n) = acc[ai][1][m][n];
                        *(f32x4*)(PE + eo + 4 * n) = (f32x4){cv[4 * n], cv[4 * n + 1], cv[4 * n + 2], cv[4 * n + 3]}; }
                }
            }
        }
    }
};
struct EpiPartial {
    static constexpr bool PERM = true, AFTER_DRAIN = false;
    float* P;
    __device__ __forceinline__ void operator()(const f32x4 (&acc)[2][2][4][2], const Unit& u, int wr, int wc, int fr, int fq) const {
        float* xo = P + ((size_t)u.ks * TCTX + (size_t)(u.pm * BM - TLAT)) * DM; const int col0 = u.pn * BM + wc * 32 + 8 * fq;
#pragma unroll
        for (int ai = 0; ai < 2; ++ai)
#pragma unroll
            for (int m = 0; m < 4; ++m) { const size_t off = (size_t)(wr * 64 + fr + ai * HALF + m * 16) * DM + col0;
#pragma unroll
                for (int bj = 0; bj < 2; ++bj)
#pragma unroll
                    for (int n = 0; n < 2; ++n) *(f32x4*)(xo + off + bj * HALF + 4 * n) = acc[ai][bj][m][n]; }
    }
};
struct EpiAll {
    static constexpr bool PERM = true, AFTER_DRAIN = false;
    int mode, ldc; const void* a0; const void* a1; const void* a2; const void* a3; const void* a4; const void* x1a; const void* x1b;
    __device__ __forceinline__ void operator()(const f32x4 (&acc)[2][2][4][2], const Unit& u, int wr, int wc, int fr_, int fq_) const {
        int ln = (int)__builtin_amdgcn_mbcnt_hi(~0u, __builtin_amdgcn_mbcnt_lo(~0u, 0u)); asm volatile("" : "+v"(ln));
        const int fr = ln & 15, fq = ln >> 4; (void)fr_; (void)fq_;
        if (mode == 0) { EpiStore E{(bf16_t*)a0, ldc}; E(acc, u, wr, wc, fr, fq); }
        else if (mode == 1) { EpiResid E{(const float*)a0, (const float*)a1, (float*)a2, (float*)a3, (const float*)a4, 0, (bf16_t*)x1a, (bf16_t*)x1b, ldc}; E(acc, u, wr, wc, fr, fq); }
        else if (mode == 2) { EpiFfUp E{(bf16_t*)a0, (const float*)a1, (float*)a2, (float*)a2 + EDGE_N, (float*)a2 + 2 * EDGE_N}; E(acc, u, wr, wc, fr, fq); }
        else if (mode == 3) { EpiPartial E{(float*)a3}; E(acc, u, wr, wc, fr, fq); }
        else if (mode == 4) { EpiKv E{(bf16_t*)a0, (const float*)a1, (__attribute__((address_space(3))) float*)(131072u)}; E(acc, u, wr, wc, fr, fq); }
        else { EpiIn E{(unsigned char*)a0, (const float*)a1, (const float*)a2, (const float*)a3, (__attribute__((address_space(3))) float*)(131072u)}; E(acc, u, wr, wc, fr, fq); }
    }
};
}

__device__ __forceinline__ void tr_item(const float* W, int N, int k0, int n0, bf16* WT, int Kd, int dst_row0, LAS float* scr, int lane, bool fold, const float* pw, const float* ps) {
#pragma unroll 8
    for (int i = 0; i < 32; ++i) { const int kk = 2 * i + (lane >> 5); scr[kk * 33 + (lane & 31)] = W[(size_t)(k0 + kk) * N + n0 + (lane & 31)]; }
    LDS_WAIT(); asm volatile("" ::: "memory");
    if (fold) {
        const int n = lane & 31, c0 = (lane >> 5) * 32; float res[32];
#pragma unroll
        for (int cc = 0; cc < 32; ++cc) res[cc] = 0.f;
        for (int d = 0; d < 64; ++d) { const float s = scr[d * 33 + n] * ps[d];
#pragma unroll
            for (int cc = 0; cc < 32; ++cc) res[cc] += pw[(c0 + cc) * 64 + d] * s; }
        LDS_WAIT(); asm volatile("" ::: "memory");
#pragma unroll
        for (int cc = 0; cc < 32; ++cc) scr[(c0 + cc) * 33 + n] = res[cc];
        LDS_WAIT(); asm volatile("" ::: "memory");
    }
    const int c = lane & 7;
#pragma unroll
    for (int j = 0; j < 4; ++j) { const int n = (lane >> 3) + 8 * j; const LAS float* s = scr + (8 * c) * 33 + n;
        v4u o; o.x = pk2(s[0 * 33], s[1 * 33]); o.y = pk2(s[2 * 33], s[3 * 33]); o.z = pk2(s[4 * 33], s[5 * 33]); o.w = pk2(s[6 * 33], s[7 * 33]);
        *(v4u*)(WT + (size_t)(dst_row0 + n) * Kd + k0 + 8 * c) = o; }
    LDS_WAIT(); asm volatile("" ::: "memory");
}

__device__ __forceinline__ void norm_mod_pass(const float* xlat, float* xctx, const float* gvec, const float* modL, int ch_sh, int ch_sc, bf16* H, int nrows, int gw, int NGW, int lane, const bf16* x1a, const bf16* x1b, const float* P, int nsplit, const float* pgate) {
    const int nrows_main = (nsplit > 0 && nrows > TLAT) ? TLAT : nrows;
    for (int chk = gw; chk < nrows_main / 16; chk += NGW) {
        const int r0 = chk * 16; const int j = r0 < TLAT ? r0 / SEQ : 4;
        const float* sc = modL + j * 6144 + ch_sc * 1024; const float* sh = modL + j * 6144 + ch_sh * 1024;
        f32x4 gm[4], sv[4];
#pragma unroll
        for (int jj = 0; jj < 4; ++jj) { const int c = 4 * lane + 256 * jj; gm[jj] = *(const f32x4*)(gvec + c) * (*(const f32x4*)(sc + c) + 1.0f); sv[jj] = *(const f32x4*)(sh + c); }
        f32x4 v[4], vn[4];
#define NROW_LOAD(dst, r_) do { if (x1a != nullptr && (r_) < TLAT) { const bf16* xb_ = (r_) < X1_SPLIT ? x1a + (size_t)(r_) * DM : x1b + (size_t)((r_) - X1_SPLIT) * DM; \
            _Pragma("unroll") for (int jj = 0; jj < 4; ++jj) { const v2u w_ = *(const v2u*)(xb_ + 4 * lane + 256 * jj); dst[jj] = (f32x4){bflo(w_.x), bfhi(w_.x), bflo(w_.y), bfhi(w_.y)}; } } \
          else { const float* xr_ = (r_) < TLAT ? xlat + (size_t)(r_) * DM : xctx + (size_t)((r_) - TLAT) * DM; _Pragma("unroll") for (int jj = 0; jj < 4; ++jj) dst[jj] = *(const f32x4*)(xr_ + 4 * lane + 256 * jj); } } while (0)
        NROW_LOAD(v, r0);
        for (int rr = 0; rr < 16; ++rr) { const int r = r0 + rr;
            if (rr + 1 < 16) { const int r1 = r + 1; NROW_LOAD(vn, r1); }
            float ss = 0.f;
#pragma unroll
            for (int jj = 0; jj < 4; ++jj) ss += (v[jj].x * v[jj].x + v[jj].y * v[jj].y) + (v[jj].z * v[jj].z + v[jj].w * v[jj].w);
            ss = wave_sum(ss); const float rs = 1.0f / sqrtf(ss * (1.0f / DM) + EPSN);
#pragma unroll
            for (int jj = 0; jj < 4; ++jj) { const f32x4 o = v[jj] * rs * gm[jj] + sv[jj]; v2u w; w.x = pk2(o.x, o.y); w.y = pk2(o.z, o.w);
                *(v2u*)(H + (size_t)r * DM + 4 * lane + 256 * jj) = w; }
#pragma unroll
            for (int jj = 0; jj < 4; ++jj) v[jj] = vn[jj];
        }
    }
    if (nrows_main < nrows) {
        const float* sc = modL + 4 * 6144 + ch_sc * 1024; const float* sh = modL + 4 * 6144 + ch_sh * 1024;
        for (int r = TLAT + gw; r < nrows; r += NGW) {
            f32x4 v[4], pp_[4][11];
#pragma unroll
            for (int jj = 0; jj < 4; ++jj) { const int cidx = 4 * lane + 256 * jj; v[jj] = *(const f32x4*)(xctx + (size_t)(r - TLAT) * DM + cidx);
#pragma unroll
                for (int s = 0; s < 11; ++s) { const int se = s < nsplit ? s : nsplit - 1; pp_[jj][s] = *(const f32x4*)(P + ((size_t)se * TCTX + (r - TLAT)) * DM + cidx); } }
            float ss = 0.f;
#pragma unroll
            for (int jj = 0; jj < 4; ++jj) { const int cidx = 4 * lane + 256 * jj; f32x4 a = (f32x4){0.f, 0.f, 0.f, 0.f};
#pragma unroll
                for (int s = 0; s < 11; ++s) a += pp_[jj][s] * (s < nsplit ? 1.f : 0.f);
                v[jj] += *(const f32x4*)(pgate + cidx) * a; *(f32x4*)(xctx + (size_t)(r - TLAT) * DM + cidx) = v[jj];
                ss += (v[jj].x * v[jj].x + v[jj].y * v[jj].y) + (v[jj].z * v[jj].z + v[jj].w * v[jj].w); }
            ss = wave_sum(ss); const float rs = 1.0f / sqrtf(ss * (1.0f / DM) + EPSN);
#pragma unroll
            for (int jj = 0; jj < 4; ++jj) { const int cidx = 4 * lane + 256 * jj; const f32x4 gmv = *(const f32x4*)(gvec + cidx) * (*(const f32x4*)(sc + cidx) + 1.0f);
                const f32x4 o = v[jj] * rs * gmv + *(const f32x4*)(sh + cidx); v2u w; w.x = pk2(o.x, o.y); w.y = pk2(o.z, o.w);
                *(v2u*)(H + (size_t)r * DM + cidx) = w; }
        }
    }
}

__device__ __forceinline__ float rope_lane(float v, int n, int lane, const float* rope) {
    const int axis = lane >> 5, half = (lane >> 4) & 1, f = lane & 15; const int pos = axis ? (n & 63) : (n >> 6);
    const float c = rope[(pos * 16 + f) * 2], s = rope[(pos * 16 + f) * 2 + 1];
    const float partner = __shfl_xor(v, 16);
    return half ? v * c + partner * s : v * c - partner * s;
}

__global__ void __launch_bounds__(512) mega(Params p) {
    extern __shared__ __attribute__((aligned(16))) unsigned char lds[];
    cg::grid_group grid = cg::this_grid();
    CParams* pp = (CParams*)__builtin_amdgcn_kernarg_segment_ptr();
    const int ph_lo = pp->ph_lo, ph_hi = pp->ph_hi;
    { const int t0 = tidx(); volatile LAS unsigned* bar_st0 = (volatile LAS unsigned*)((LAS unsigned char*)lds + LDS_ST_OFF); unsigned* barw0 = (unsigned*)(pp->ws + WS_BAR);
      if (t0 < 2) bar_st0[t0] = 0u;
      if (blockIdx.x == 0) for (int i = t0; i < XCD_BAR_WORDS; i += 512) barw0[i] = 0u;
      __syncthreads(); }
    for (int ph = ph_lo; ph < ph_hi; ++ph) {
        asm volatile("" : "+s"(pp));
#define p (*pp)
        const int G = gridDim.x, bx = blockIdx.x;
        const int vcu = (G % 8 == 0) ? (bx % 8) * (G / 8) + bx / 8 : bx;
#define DEF_TID const int tid = tidx(), lane = tid & 63, wave = __builtin_amdgcn_readfirstlane(tid >> 6); const int gw = bx * 8 + wave, NGW = G * 8; (void)tid; (void)lane; (void)gw; (void)NGW;
        unsigned char* ws = p.ws;
        float* mod = (float*)(ws + WS_MOD); float* rope = (float*)(ws + WS_ROPE); float* XC = (float*)(ws + WS_XC);
        bf16* Wb = (bf16*)(ws + WS_W); bf16* H = (bf16*)(ws + WS_H); bf16* Y = (bf16*)(ws + WS_Y); bf16* QL = (bf16*)(ws + WS_QL); bf16* KVL = (bf16*)(ws + WS_KVL);
        bf16* Q = (bf16*)(ws + WS_Q); bf16* KV = (bf16*)(ws + WS_KV); bf16* KR = (bf16*)(ws + WS_KR); bf16* MIX = (bf16*)(ws + WS_MIX); bf16* HID = (bf16*)(ws + WS_HID);
        float* GE = (float*)(ws + WS_EDGE); float* PE = GE + EDGE_N; float* UE = PE + EDGE_N;
        float* out = p.out; float* PART_WO = (float*)(ws + WS_PART_WO); float* PART_DN = (float*)(ws + WS_PART_DN); bf16* X1A = (bf16*)(ws + WS_X1A); bf16* X1B = (bf16*)(ws + WS_X1B);

        if (ph == 0) { { DEF_TID
            LAS float* sv = (LAS float*)lds; LAS float* red = (LAS float*)(lds + 20480);
            for (int i = tid; i < 5 * 1024; i += 512) { const float v = i < 4096 ? p.in[1][i] : p.in[3][i - 4096]; sv[i] = v / (1.f + __expf(-v)); }
            __syncthreads();
            for (int it = bx; it < DEPTH * 96; it += G) {
                const int i = it / 96, nb = it % 96; const float* Wp = p.in[4] + (size_t)i * 1024 * 6144 + nb * 64 + lane;
                float a0 = 0.f, a1 = 0.f, a2 = 0.f, a3 = 0.f, a4 = 0.f;
#pragma unroll 8
                for (int kk = 0; kk < 128; ++kk) { const int k = wave * 128 + kk; const float w = Wp[(size_t)k * 6144];
                    a0 += sv[k] * w; a1 += sv[1024 + k] * w; a2 += sv[2048 + k] * w; a3 += sv[3072 + k] * w; a4 += sv[4096 + k] * w; }
                red[(wave * 5 + 0) * 64 + lane] = a0; red[(wave * 5 + 1) * 64 + lane] = a1; red[(wave * 5 + 2) * 64 + lane] = a2; red[(wave * 5 + 3) * 64 + lane] = a3; red[(wave * 5 + 4) * 64 + lane] = a4;
                __syncthreads();
                if (tid < 320) { const int j = tid >> 6, l = tid & 63; float s = 0.f;
#pragma unroll
                    for (int w = 0; w < 8; ++w) s += red[(w * 5 + j) * 64 + l];
                    mod[((size_t)i * 5 + j) * 6144 + nb * 64 + l] = s + p.in[5][(size_t)i * 6144 + nb * 64 + l]; }
                __syncthreads();
            }
            { const int gt = bx * 512 + tid;
              if (gt < 2048) { const int pos = gt >> 4, f = gt & 15; const float inv = exp2f(-(float)f * (13.287712379549449f / 16.f)); const float ang = (float)pos * inv;
                  const float rev = ang * 0.15915494309189535f; const float fr = rev - rintf(rev);
                  rope[gt * 2] = __builtin_amdgcn_cosf(fr); rope[gt * 2 + 1] = __builtin_amdgcn_sinf(fr); }
              for (int i = gt; i < TCTX * DM / 4; i += G * 512) ((f32x4*)XC)[i] = ((const f32x4*)p.in[2])[i];
              unsigned zz = 0u; asm volatile("" : "+v"(zz));
              for (int i = gt; i < DEPTH * 8192; i += G * 512) { const int l = i >> 13, r = i & 8191;
                  *(v4u*)(Wb + (size_t)l * W_LAYER + WO_IN + (size_t)INW * DM + (size_t)r * 8) = (v4u){zz, zz, zz, zz}; } }
            LAS float* scr = (LAS float*)(lds + 32768 + wave * 8448);
            for (int it = gw; it < DEPTH * 5632; it += NGW) {
                const int l = it / 5632; int r = it % 5632; bf16* WL = Wb + (size_t)l * W_LAYER;
                if (r < 736) { const int kb = r / 46, nb = r % 46; tr_item(p.in[8] + (size_t)l * DM * INW, INW, kb * 64, nb * 32, WL + WO_IN, DM, nb * 32, scr, lane, false, nullptr, nullptr); continue; } r -= 736;
                if (r < 96) { const int kb = r / 24, nb = r % 24; tr_item(p.in[11] + (size_t)l * QRK * 768, 768, kb * 64, nb * 32, WL + WO_Q, QRK, nb * 32, scr, lane, false, nullptr, nullptr); continue; } r -= 96;
                if (r < 64) { const int kb = r / 32, nb = r % 32; tr_item(p.in[12] + (size_t)l * KVRK * 1024, 1024, kb * 64, nb * 32, WL + WO_KV, KVRK, nb * 32, scr, lane, false, nullptr, nullptr); continue; } r -= 64;
                if (r < 512) { const int kb = r / 32, nb = r % 32; const bool fold = (kb >= 8 && kb < 12); const int g = kb - 8;
                    tr_item(p.in[20] + (size_t)l * DM * DM, DM, kb * 64, nb * 32, WL + WO_O, DM, nb * 32, scr, lane, fold, p.in[17] + (size_t)l * 16384 + (fold ? g * 4096 : 0), p.in[18] + (size_t)l * 256 + (fold ? g * 64 : 0)); continue; } r -= 512;
                if (r < 2816) { const int kb = r / 176, nb = r % 176; const int n0 = nb * 32, half = n0 >= DFF ? 1 : 0, ch = n0 - half * DFF; const int drow = 256 * (ch >> 7) + 128 * half + (ch & 127);
                    tr_item(p.in[21] + (size_t)l * DM * 2 * DFF, 2 * DFF, kb * 64, n0, WL + WO_UP, DM, drow, scr, lane, false, nullptr, nullptr); continue; } r -= 2816;
                { const int kb = r / 32, nb = r % 32; tr_item(p.in[23] + (size_t)l * DFF * DM, DM, kb * 64, nb * 32, WL + WO_DN, DFF, nb * 32, scr, lane, false, nullptr, nullptr); }
            }
        } } else {
            const int L = (ph - 1) / 9, k9 = (ph - 1) % 9, k = k9 < 4 ? k9 : (k9 < 8 ? k9 + 1 : 10);
            const bf16* WL = Wb + (size_t)L * W_LAYER;
            const float* modL = mod + (size_t)L * 5 * 6144;
            const float* xlat = (L == 0) ? p.in[0] : out; const float* xctx = XC;
            const int Mact = (L == DEPTH - 1) ? TLAT : TT;
            if (k == 0) { DEF_TID
                norm_mod_pass(xlat, XC, p.in[6] + L * DM, modL, 0, 1, H, TT, gw, NGW, lane, nullptr, nullptr, PART_DN, (L > 0) ? DFF / 256 : 0, modL - 5 * 6144 + 4 * 6144 + 5 * 1024);
            } else if (k == 2) { DEF_TID
                const float* scw = p.in[19] + L * 3 * 256;
                const int ch = 4 * lane, grp = lane >> 4, hw = 1 << grp;
                const f32x4 cw0 = *(const f32x4*)(scw + ch), cw1 = *(const f32x4*)(scw + 256 + ch), cw2 = *(const f32x4*)(scw + 512 + ch);
                for (int t0 = gw * 4; t0 < TT; t0 += NGW * 4)
                for (int ti = 0; ti < 4; ++ti) { const int t = t0 + ti;
                    const bf16* y = Y + (size_t)t * INP; const bool lat = t < TLAT; const int n = lat ? (t & (SEQ - 1)) : ((t - TLAT) & (CTXL - 1)); const int len = lat ? SEQ : CTXL;
                    const bool hp = n > 0, hn = n < len - 1; const long op = hp ? -(long)INP : 0, on = hn ? (long)INP : 0; const float fp = hp ? 1.f : 0.f, fn = hn ? 1.f : 0.f;
                    const v2u gb = *(const v2u*)(y + 704 + ch), c1 = *(const v2u*)(y + 960 + ch), i1 = *(const v2u*)(y + 1216 + ch);
                    const v2u c0 = *(const v2u*)(y + op + 960 + ch), i0 = *(const v2u*)(y + op + 1216 + ch), c2 = *(const v2u*)(y + on + 960 + ch), i2 = *(const v2u*)(y + on + 1216 + ch);
                    v2u pv[16]; float pw[16];
#pragma unroll
                    for (int d = -8; d < 8; ++d) { const int s = n + d; const bool ok = d >= -hw && d < hw && s >= 0 && s < len; pw[d + 8] = ok ? 1.f : 0.f;
                        pv[d + 8] = *(const v2u*)(y + (ok ? (long)d * INP : 0) + 448 + ch); }
                    { const f32x4 w0 = cw0 * fp, w2 = cw2 * fn;
                      const float o0 = bflo(gb.x) * (w0.x * bflo(c0.x) * bflo(i0.x) + cw1.x * bflo(c1.x) * bflo(i1.x) + w2.x * bflo(c2.x) * bflo(i2.x));
                      const float o1 = bfhi(gb.x) * (w0.y * bfhi(c0.x) * bfhi(i0.x) + cw1.y * bfhi(c1.x) * bfhi(i1.x) + w2.y * bfhi(c2.x) * bfhi(i2.x));
                      const float o2 = bflo(gb.y) * (w0.z * bflo(c0.y) * bflo(i0.y) + cw1.z * bflo(c1.y) * bflo(i1.y) + w2.z * bflo(c2.y) * bflo(i2.y));
                      const float o3 = bfhi(gb.y) * (w0.w * bfhi(c0.y) * bfhi(i0.y) + cw1.w * bfhi(c1.y) * bfhi(i1.y) + w2.w * bfhi(c2.y) * bfhi(i2.y));
                      v2u w; w.x = pk2(o0, o1); w.y = pk2(o2, o3); *(v2u*)(MIX + (size_t)t * DM + 768 + ch) = w; }
                    { float s0 = 0.f, s1 = 0.f, s2 = 0.f, s3 = 0.f;
#pragma unroll
                      for (int j = 0; j < 16; ++j) { s0 += pw[j] * bflo(pv[j].x); s1 += pw[j] * bfhi(pv[j].x); s2 += pw[j] * bflo(pv[j].y); s3 += pw[j] * bfhi(pv[j].y); }
                      const int lo = (n - hw) > 0 ? (n - hw) : 0, hi = (n + hw) < len ? (n + hw) : len; const float icnt = 1.0f / (float)(hi - lo);
                      const v2u pc = pv[8];
                      v2u w; w.x = pk2(s0 * icnt - bflo(pc.x), s1 * icnt - bfhi(pc.x)); w.y = pk2(s2 * icnt - bflo(pc.y), s3 * icnt - bfhi(pc.y)); *(v2u*)(MIX + (size_t)t * DM + 512 + ch) = w; }
                }
            } else if (k == 4) { DEF_TID
                const float* kn_g = p.in[15] + L * 128; const int hh = lane >> 4, dd = (lane & 15) * 8;
                const f32x4 kga = *(const f32x4*)(kn_g + dd), kgb = *(const f32x4*)(kn_g + dd + 4);
                for (int t0 = gw * 4; t0 < TT; t0 += NGW * 4) {
                    v4u rk[4];
#pragma unroll
                    for (int ti = 0; ti < 4; ++ti) rk[ti] = *(const v4u*)(KV + (size_t)(t0 + ti) * 1024 + hh * 256 + dd);
#pragma unroll
                    for (int ti = 0; ti < 4; ++ti) {
                        const float f0 = bflo(rk[ti].x), f1 = bfhi(rk[ti].x), f2 = bflo(rk[ti].y), f3 = bfhi(rk[ti].y), f4 = bflo(rk[ti].z), f5 = bfhi(rk[ti].z), f6 = bflo(rk[ti].w), f7 = bfhi(rk[ti].w);
                        float ss = ((f0 * f0 + f1 * f1) + (f2 * f2 + f3 * f3)) + ((f4 * f4 + f5 * f5) + (f6 * f6 + f7 * f7));
                        ss += __builtin_bit_cast(float, __builtin_amdgcn_update_dpp(0, __builtin_bit_cast(int, ss), 0xB1, 0xF, 0xF, true));
                        ss += __builtin_bit_cast(float, __builtin_amdgcn_update_dpp(0, __builtin_bit_cast(int, ss), 0x4E, 0xF, 0xF, true));
                        ss += __builtin_bit_cast(float, __builtin_amdgcn_update_dpp(0, __builtin_bit_cast(int, ss), 0x141, 0xF, 0xF, true));
                        ss += __builtin_bit_cast(float, __builtin_amdgcn_update_dpp(0, __builtin_bit_cast(int, ss), 0x140, 0xF, 0xF, true));
                        const float rs = 1.0f / sqrtf(ss * (1.0f / 128) + EPSN);
                        v4u w; w.x = pk2(f0 * rs * kga.x, f1 * rs * kga.y); w.y = pk2(f2 * rs * kga.z, f3 * rs * kga.w); w.z = pk2(f4 * rs * kgb.x, f5 * rs * kgb.y); w.w = pk2(f6 * rs * kgb.z, f7 * rs * kgb.w);
                        *(v4u*)(KV + (size_t)(t0 + ti) * 1024 + hh * 256 + dd) = w; }
                }
            } else if (k == 5) {
                const int NU = 512 + (L < DEPTH - 1 ? 16 : 0);
                for (int u = vcu; u < NU; u += G) {
                    int b, h, row0, lat0, nlat, ctx0, seq;
                    if (u < 512) { const int bh = u >> 5, qb = u & 31; b = bh >> 2; h = bh & 3; row0 = b * SEQ + qb * 256; lat0 = b * SEQ; nlat = SEQ; ctx0 = TLAT + b * CTXL; seq = SEQ + CTXL; }
                    else { const int j = u - 512; b = j >> 2; h = j & 3; row0 = TLAT + b * CTXL; lat0 = 0; nlat = 0; ctx0 = TLAT + b * CTXL; seq = CTXL; }
                    att::attn_unit(Q + (size_t)row0 * 768 + h * DQK, KV + h * 256, KR, MIX + (size_t)row0 * DM + h * 128, lat0, nlat, ctx0, seq, (char*)lds,
                                   p.in[13] + L * 128, p.in[14] + L * 64, rope, u < 512 ? (u & 31) * 256 : -1);
                    __syncthreads();
                }
            } else if (k == 7) { DEF_TID
                norm_mod_pass(out, XC, p.in[7] + L * DM, modL, 3, 4, H, Mact, gw, NGW, lane, X1A, X1B, PART_WO, (L < DEPTH - 1) ? DM / 128 : 0, modL + 4 * 6144 + 2 * 1024);
            } else {
                if (k == 10) {
                    const int tid = tidx(); const float* cw = p.in[22] + (size_t)L * 3 * DFF;
                    for (int gi2 = 0; gi2 < ((L < DEPTH - 1) ? 2 : 1); ++gi2) {
                        pg8::StaticOrder S2; if (gi2 == 0) S2.init(TLAT, DM, G, bx); else { S2.init(TCTX, DM, G, bx); S2.nsplit = DFF / 256; S2.pm0 = TLAT / 256; }
                        pg8::Unit u2;
                        for (int ui = 0; S2.next(ui, u2); ++ui)
                            for (int i = tid; i < 8 * (DFF / 4); i += 512) {
                                const int c = (i % (DFF / 4)) * 4, be = u2.pm * 8 + i / (DFF / 4), blk = be >> 1, e = be & 1; const int r = blk * 64 + (e ? 63 : 0);
                                f32x4 conv = *(const f32x4*)(PE + (size_t)be * DFF + c);
                                if (e == 0) { const bool start = r < TLAT ? ((r & (SEQ - 1)) == 0) : (((r - TLAT) & (CTXL - 1)) == 0);
                                    if (!start) conv += *(const f32x4*)(cw + c) * *(const f32x4*)(GE + ((size_t)(blk - 1) * 2 + 1) * DFF + c); }
                                else { const int r1 = r + 1; const bool end = r1 < TLAT ? ((r1 & (SEQ - 1)) == 0) : (((r1 - TLAT) & (CTXL - 1)) == 0);
                                    if (!end) conv += *(const f32x4*)(cw + 2 * DFF + c) * *(const f32x4*)(GE + ((size_t)(blk + 1) * 2) * DFF + c); }
                                const f32x4 uu = *(const f32x4*)(UE + (size_t)be * DFF + c);
                                v2u w; w.x = pk2(conv.x * __builtin_amdgcn_rcpf(1.f + __expf(-conv.x)) * uu.x, conv.y * __builtin_amdgcn_rcpf(1.f + __expf(-conv.y)) * uu.y);
                                w.y = pk2(conv.z * __builtin_amdgcn_rcpf(1.f + __expf(-conv.z)) * uu.z, conv.w * __builtin_amdgcn_rcpf(1.f + __expf(-conv.w)) * uu.w);
                                *(v2u*)(HID + (size_t)r * DFF + c) = w;
                            }
                    }
                    asm volatile("s_waitcnt vmcnt(0)" ::: "memory"); __syncthreads();
                }
                const bool split_ctx = (k == 6 || k == 10) && L < DEPTH - 1;
                const int ng = (k == 3 || split_ctx) ? 2 : 1;
                for (int gi = 0; gi < ng; ++gi) {
                    pg8::Gemm g; pg8::EpiAll E; E.a1 = nullptr; E.a2 = nullptr; E.a3 = nullptr; E.a4 = nullptr; E.ldc = 0; E.x1a = X1A; E.x1b = X1B; int nsplit = 1, pm0 = 0;
                    if (k == 1)      { g = pg8::Gemm{H, WL + WO_IN, TT, INP, DM, DM};      E.mode = 5; E.a0 = ws; E.a1 = p.in[9] + L * QRK; E.a2 = p.in[10] + L * KVRK; E.a3 = p.in[16] + L * 64; }
                    else if (k == 3 && gi == 0) { g = pg8::Gemm{QL, WL + WO_Q, TT, 768, QRK, QRK};   E.mode = 0; E.a0 = Q; E.ldc = 768; }
                    else if (k == 3) { g = pg8::Gemm{KVL, WL + WO_KV, TT, 1024, KVRK, KVRK}; E.mode = 4; E.a0 = KV; E.a1 = p.in[15] + L * 128; }
                    else if (k == 6 && gi == 0) { g = pg8::Gemm{MIX, WL + WO_O, TLAT, DM, DM, DM};    E.mode = 1; E.ldc = 2; E.a0 = xlat; E.a1 = XC; E.a2 = out; E.a3 = XC; E.a4 = modL + 2 * 1024; }
                    else if (k == 6) { g = pg8::Gemm{MIX, WL + WO_O, TCTX, DM, 128, DM}; nsplit = DM / 128; pm0 = TLAT / 256; E.mode = 3; E.a0 = nullptr; E.a3 = PART_WO; }
                    else if (k == 8) { g = pg8::Gemm{H, WL + WO_UP, Mact, 2 * DFF, DM, DM}; E.mode = 2; E.a0 = HID; E.a1 = p.in[22] + (size_t)L * 3 * DFF; E.a2 = GE; }
                    else if (gi == 0) { g = pg8::Gemm{HID, WL + WO_DN, TLAT, DM, DFF, DFF};  E.mode = 1; E.ldc = 1; E.a0 = out; E.a1 = XC; E.a2 = out; E.a3 = XC; E.a4 = modL + 5 * 1024; }
                    else             { g = pg8::Gemm{HID, WL + WO_DN, TCTX, DM, 256, DFF}; nsplit = DFF / 256; pm0 = TLAT / 256; E.mode = 3; E.a0 = nullptr; E.a3 = PART_DN; }
                    pg8::StaticOrder S; S.init(g.M, g.N, G, bx); S.nsplit = nsplit; S.pm0 = pm0;
                    pg8::gemm_phase<pg8::EpiAll, pg8::StaticOrder, true, true>((LAS unsigned char*)lds, g, S, E);
                }
            }
        }
        if (ph + 1 < ph_hi) {
            volatile LAS unsigned* bar_st = (volatile LAS unsigned*)((LAS unsigned char*)lds + LDS_ST_OFF); unsigned* barw = (unsigned*)(pp->ws + WS_BAR);
            if (ph == ph_lo) { grid.sync(); (void)xcd_barrier_post(barw, bar_st); }
            else { XcdBarrier xb; xb.bar = barw; xb.x = xb_xcc_id(); xb.st = bar_st; xcd_barrier(xb); } }
#undef p
    }
}

extern "C" void kernel_launch(void* const* d_in, const int* in_sizes, int n_in, void* d_out, int out_size, void* d_ws, size_t ws_size, hipStream_t stream) {
    static int grid = 0;
    if (grid == 0) {
        if (n_in != 24 || in_sizes[0] != TLAT * DM || out_size != TLAT * DM || ws_size < WS_END) { fprintf(stderr, "kernel_launch: unexpected shapes (n_in %d, ws %zu)\n", n_in, ws_size); grid = -1; return; }
        int dev = 0, cus = 0, per_cu = 0;
        hipGetDevice(&dev); hipDeviceGetAttribute(&cus, hipDeviceAttributeMultiprocessorCount, dev);
        if (hipFuncSetAttribute((const void*)mega, hipFuncAttributeMaxDynamicSharedMemorySize, LDS_BYTES) != hipSuccess) { fprintf(stderr, "kernel_launch: hipFuncSetAttribute failed\n"); grid = -1; return; }
        if (hipOccupancyMaxActiveBlocksPerMultiprocessor(&per_cu, (const void*)mega, 512, LDS_BYTES) != hipSuccess || per_cu < 1) { fprintf(stderr, "kernel_launch: occupancy query says %d\n", per_cu); per_cu = 1; }
        (void)hipGetLastError();
        grid = cus;
    }
    if (grid < 0) return;
    Params p{};
    for (int i = 0; i < 24; ++i) p.in[i] = (const float*)d_in[i];
    p.out = (float*)d_out; p.ws = (unsigned char*)d_ws;
    p.ph_lo = 0; p.ph_hi = NPH;
    void* args[] = {&p};
    hipError_t e = hipLaunchCooperativeKernel((const void*)mega, dim3(grid), dim3(512), args, LDS_BYTES, stream);
    if (e != hipSuccess) fprintf(stderr, "cooperative launch failed: %s (grid %d)\n", hipGetErrorString(e), grid);
}
```

```cpp
#include <hip/hip_runtime.h>
#include <hip/hip_cooperative_groups.h>
#include <cstdio>
#include <cstdint>
namespace cg = cooperative_groups;

constexpr int DM = 1024, NB = 4, SEQ = 8192, DEPTH = 4, CTXL = 256;
constexpr int TLAT = NB * SEQ, TCTX = NB * CTXL, TT = TLAT + TCTX;
constexpr int INW = 1472, INP = 1536, QRK = 256, KVRK = 128, NHEAD = 4, DQK = 192, DFF = 2816;
constexpr float EPSN = 1e-6f;
__device__ __forceinline__ int tidx() { int t = (int)__builtin_amdgcn_workitem_id_x(); asm volatile("" : "+v"(t)); return t; }
namespace pg8 {
#define PG8_LAS __attribute__((address_space(3)))
typedef unsigned short bf16_t;
typedef short bf16x8 __attribute__((ext_vector_type(8)));
typedef float f32x4 __attribute__((ext_vector_type(4)));
typedef unsigned u32x4 __attribute__((ext_vector_type(4)));
constexpr int BM = 256, BK = 64, HALF = 128, HTB = HALF * BK * 2  , STAGE_BYTES = 8 * HTB, NXCD = 8, WGM = 8;

__host__ __device__ __forceinline__ int lds_byte(int r, int c) { const int st = (r >> 4) * 2 + (c >> 5), rr = r & 15, cc = c & 31, ob = rr * 64 + cc * 2; return st * 1024 + (ob ^ (((ob >> 9) & 1) << 5)); }
__host__ __device__ __forceinline__ void stage_rc(int b, int& R, int& C) { const int st = b / 1024, sb = b % 1024, swz = sb ^ (((sb >> 9) & 1) << 5); R = (st >> 1) * 16 + swz / 64; C = (st & 1) * 32 + (swz % 64) / 2; }
__host__ __device__ __forceinline__ int perm32(int rho) { const int n = rho >> 4, i = rho & 15; return 8 * (i >> 2) + 4 * n + (i & 3); }

struct Unit { int pm, pn, ks; };
struct Gemm { const bf16_t* A; const bf16_t* Bt; int M, N, K, ld; };

struct StaticOrder {
    int nM, nN, nwg, G, c;
    __host__ __device__ void init(int M, int N, int G_, int c_) { nM = M / BM; nN = N / BM; nwg = nM * nN; G = G_; c = c_; }
    int nsplit = 1, pm0 = 0;
    __host__ __device__ bool next(int i, Unit& u) const {
        if (nsplit > 1 || pm0 > 0) { const long Ls = (long)i * G + c; if (Ls >= (long)nwg * nsplit) return false; const int t = (int)(Ls / nsplit); u.ks = (int)(Ls % nsplit); u.pn = t % nN; u.pm = pm0 + t / nN; return true; }
        const long L = (long)i * G + c; if (L >= nwg) return false;
        int wgid = (int)L; { const int q = nwg / NXCD, r = nwg % NXCD, xcd = wgid % NXCD, off = wgid / NXCD; wgid = (xcd < r ? xcd * (q + 1) : r * (q + 1) + (xcd - r) * q) + off; }
        const int nig = WGM * nN, gid = wgid / nig, fm = gid * WGM, gsz = (nM - fm) < WGM ? (nM - fm) : WGM;
        u.pm = fm + ((wgid % nig) % gsz); u.pn = (wgid % nig) / gsz; u.ks = 0; return true;
    }
    __device__ __forceinline__ void a_ready(const Unit&) const {}
    __device__ __forceinline__ void done(const Unit&) const {}
};

__device__ __forceinline__ unsigned cvt_pk_bf16(float lo, float hi) { unsigned r; asm volatile("v_cvt_pk_bf16_f32 %0, %1, %2" : "=v"(r) : "v"(lo), "v"(hi)); return r; }
template <class Epi, class Sched, bool ALIGN_EPI = false, bool SP2 = false>
__device__ __forceinline__ void gemm_phase(PG8_LAS unsigned char* lds, const Gemm g, const Sched& S, const Epi& E) {
    const int tid = tidx(), wid = __builtin_amdgcn_readfirstlane(tid >> 6), lane = tid & 63, wr = wid >> 2, wc = wid & 3, fr = lane & 15, fq = lane >> 4;
    const int K = g.K, nt = K / BK;
    unsigned voffA[2], voffB[2];
#pragma unroll
    for (int i = 0; i < 2; ++i) { int R, C; stage_rc(tid * 16 + i * 8192, R, C); const int Rb = Epi::PERM ? ((R & ~31) + perm32(R & 31)) : R;
        voffA[i] = (unsigned)(R * g.ld + C) * 2u; voffB[i] = (unsigned)(Rb * g.ld + C) * 2u; }
    const size_t kstep = (size_t)(BK * 2);
    const size_t hstep = (size_t)HALF * g.ld * 2, kslice = (size_t)K * 2;
    const size_t tstep = 2 * hstep;
    const unsigned ldsw = (unsigned)wid * 1024u;
    const int aoff = lds_byte(wr * 64 + fr, fq * 8), boff = lds_byte(wc * 32 + fr, fq * 8);
#define PG8_SA(b, h) (((b) * 2 + (h)) * HTB)
#define PG8_SB(b, h) ((4 + (b) * 2 + (h)) * HTB)
#define PG8_STAGE(bufoff, gbase, voff) do { _Pragma("unroll") for (int _i = 0; _i < 2; ++_i) \
        __builtin_amdgcn_global_load_lds((const unsigned*)((const char*)(gbase) + (voff)[_i]), (PG8_LAS unsigned*)(lds + (bufoff) + ldsw + _i * 8192), 16, 0, 0); } while (0)
#define PG8_LDA(dst, b, h) do { _Pragma("unroll") for (int m = 0; m < 4; ++m) _Pragma("unroll") for (int k = 0; k < 2; ++k) dst[m][k] = *(const PG8_LAS bf16x8*)(lds + PG8_SA(b, h) + aoff + m * 2048 + k * 1024); } while (0)
#define PG8_LDB(dst, b, h) do { _Pragma("unroll") for (int n = 0; n < 2; ++n) _Pragma("unroll") for (int k = 0; k < 2; ++k) dst[n][k] = *(const PG8_LAS bf16x8*)(lds + PG8_SB(b, h) + boff + n * 2048 + k * 1024); } while (0)
#define PG8_MMA(ai, bj, At, Bt) do { __builtin_amdgcn_s_setprio(1); _Pragma("unroll") for (int m = 0; m < 4; ++m) _Pragma("unroll") for (int n = 0; n < 2; ++n) _Pragma("unroll") for (int k = 0; k < 2; ++k) \
        acc[ai][bj][m][n] = __builtin_amdgcn_mfma_f32_16x16x32_bf16(Bt[n][k], At[m][k], acc[ai][bj][m][n], 0, 0, 0); __builtin_amdgcn_s_setprio(0); } while (0)
#define PG8_WAIT_V(n) asm volatile("s_waitcnt vmcnt(" #n ")" ::: "memory")
#define PG8_WAIT_L(n) asm volatile("s_waitcnt lgkmcnt(" #n ")" ::: "memory")
#define PG8_BAR __builtin_amdgcn_s_barrier()
#define PG8_SCHED __builtin_amdgcn_sched_barrier(0)
    Unit cur, nxt; int ui = 0;
    if (!S.next(0, cur)) return;
    f32x4 acc[2][2][4][2];
#pragma unroll
    for (int a = 0; a < 2; ++a)
#pragma unroll
        for (int b = 0; b < 2; ++b)
#pragma unroll
            for (int m = 0; m < 4; ++m)
#pragma unroll
                for (int n = 0; n < 2; ++n) acc[a][b][m][n] = (f32x4){0.f, 0.f, 0.f, 0.f};
    bf16x8 At[4][2], B0[2][2], B1[2][2];
    const char* cA = (const char*)g.A + (size_t)cur.pm * tstep + cur.ks * kslice; const char* cB = (const char*)g.Bt + (size_t)cur.pn * tstep + cur.ks * kslice;
    S.a_ready(cur);
    if constexpr (SP2) {
        PG8_STAGE(PG8_SB(0, 0), cB, voffB); PG8_STAGE(PG8_SB(0, 1), cB + hstep, voffB); PG8_STAGE(PG8_SA(0, 0), cA, voffA); PG8_STAGE(PG8_SA(0, 1), cA + hstep, voffA);
        if (wr == 1) PG8_BAR;
        PG8_WAIT_V(2); PG8_BAR;
        PG8_STAGE(PG8_SB(1, 0), cB + kstep, voffB); PG8_STAGE(PG8_SA(1, 0), cA + kstep, voffA); PG8_STAGE(PG8_SB(1, 1), cB + hstep + kstep, voffB);
        PG8_WAIT_V(6); PG8_BAR;
    } else {
        PG8_STAGE(PG8_SB(0, 0), cB, voffB); PG8_STAGE(PG8_SA(0, 0), cA, voffA); PG8_STAGE(PG8_SB(0, 1), cB + hstep, voffB); PG8_STAGE(PG8_SA(0, 1), cA + hstep, voffA);
        if (wr == 1) PG8_BAR;
        PG8_WAIT_V(4); PG8_BAR;
        PG8_STAGE(PG8_SB(1, 0), cB + kstep, voffB); PG8_STAGE(PG8_SA(1, 0), cA + kstep, voffA); PG8_STAGE(PG8_SB(1, 1), cB + hstep + kstep, voffB);
        PG8_WAIT_V(6); PG8_BAR;
    }
    for (;;) {
        const bool has_next = S.next(ui + 1, nxt);
        const char* nA = has_next ? (const char*)g.A + (size_t)nxt.pm * tstep + nxt.ks * kslice : cA; const char* nB = has_next ? (const char*)g.Bt + (size_t)nxt.pn * tstep + nxt.ks * kslice : cB;
        for (int t = 0; t < nt; t += 2) {
            const bool last = (t == nt - 2);
            const char* a1 = cA + (size_t)(t + 1) * kstep;
            const char* a2 = last ? nA : cA + (size_t)(t + 2) * kstep; const char* b2 = last ? nB : cB + (size_t)(t + 2) * kstep;
            const char* a3 = a2 + kstep; const char* b3 = b2 + kstep;
            if (last && has_next) S.a_ready(nxt);
            if constexpr (SP2) {
            PG8_LDB(B0, 0, 0); PG8_LDB(B1, 0, 1); PG8_SCHED; PG8_LDA(At, 0, 0); PG8_STAGE(PG8_SA(1, 1), a1 + hstep, voffA);
            PG8_WAIT_V(8); PG8_WAIT_L(0); PG8_BAR; PG8_MMA(0, 0, At, B0); PG8_MMA(0, 1, At, B1); PG8_BAR; PG8_SCHED;
            PG8_LDA(At, 0, 1); PG8_STAGE(PG8_SB(0, 0), b2, voffB); PG8_STAGE(PG8_SB(0, 1), b2 + hstep, voffB); PG8_STAGE(PG8_SA(0, 0), a2, voffA);
            PG8_WAIT_V(8); PG8_WAIT_L(0); PG8_BAR; PG8_MMA(1, 0, At, B0); PG8_MMA(1, 1, At, B1); PG8_BAR; PG8_SCHED;
            PG8_LDB(B0, 1, 0); PG8_LDB(B1, 1, 1); PG8_SCHED; PG8_LDA(At, 1, 0); PG8_STAGE(PG8_SA(0, 1), a2 + hstep, voffA);
            PG8_WAIT_V(8); PG8_WAIT_L(0); PG8_BAR; PG8_MMA(0, 0, At, B0); PG8_MMA(0, 1, At, B1); PG8_BAR; PG8_SCHED;
            PG8_LDA(At, 1, 1); PG8_STAGE(PG8_SB(1, 0), b3, voffB); PG8_STAGE(PG8_SB(1, 1), b3 + hstep, voffB); PG8_STAGE(PG8_SA(1, 0), a3, voffA);
            PG8_WAIT_V(8); PG8_WAIT_L(0); PG8_BAR; PG8_MMA(1, 0, At, B0); PG8_MMA(1, 1, At, B1); PG8_BAR; PG8_SCHED;
            } else {
            PG8_LDB(B0, 0, 0); PG8_SCHED; PG8_LDA(At, 0, 0); PG8_STAGE(PG8_SA(1, 1), a1 + hstep, voffA);
            PG8_WAIT_L(8); PG8_BAR; PG8_WAIT_L(0); PG8_MMA(0, 0, At, B0); PG8_BAR; PG8_SCHED;
            PG8_LDB(B1, 0, 1); PG8_STAGE(PG8_SB(0, 0), b2, voffB);
            PG8_BAR; PG8_WAIT_L(0); PG8_MMA(0, 1, At, B1); PG8_BAR;
            PG8_LDA(At, 0, 1); PG8_STAGE(PG8_SA(0, 0), a2, voffA);
            PG8_BAR; PG8_WAIT_L(0); PG8_MMA(1, 0, At, B0); PG8_BAR; PG8_SCHED;
            PG8_STAGE(PG8_SB(0, 1), b2 + hstep, voffB);
            PG8_WAIT_V(6); PG8_BAR; PG8_MMA(1, 1, At, B1); PG8_BAR;
            PG8_LDB(B0, 1, 0); PG8_SCHED; PG8_LDA(At, 1, 0); PG8_STAGE(PG8_SA(0, 1), a2 + hstep, voffA);
            PG8_WAIT_L(8); PG8_BAR; PG8_WAIT_L(0); PG8_MMA(0, 0, At, B0); PG8_BAR; PG8_SCHED;
            PG8_LDB(B1, 1, 1); PG8_STAGE(PG8_SB(1, 0), b3, voffB);
            PG8_BAR; PG8_WAIT_L(0); PG8_MMA(0, 1, At, B1); PG8_BAR;
            PG8_LDA(At, 1, 1); PG8_STAGE(PG8_SA(1, 0), a3, voffA);
            PG8_BAR; PG8_WAIT_L(0); PG8_MMA(1, 0, At, B0); PG8_BAR; PG8_SCHED;
            PG8_STAGE(PG8_SB(1, 1), b3 + hstep, voffB);
            PG8_WAIT_V(6); PG8_BAR; PG8_MMA(1, 1, At, B1); PG8_BAR;
            }
        }
        if constexpr (ALIGN_EPI) { if (wr == 0) PG8_BAR; }
        if constexpr (!Epi::AFTER_DRAIN) { E(acc, cur, wr, wc, fr, fq); S.done(cur); }
        if (!has_next) break;
#pragma unroll
        for (int a = 0; a < 2; ++a)
#pragma unroll
            for (int b = 0; b < 2; ++b)
#pragma unroll
                for (int m = 0; m < 4; ++m)
#pragma unroll
                    for (int n = 0; n < 2; ++n) acc[a][b][m][n] = (f32x4){0.f, 0.f, 0.f, 0.f};
        cur = nxt; cA = nA; cB = nB; ++ui;
        if constexpr (ALIGN_EPI) { if (wr == 1) PG8_BAR; }
    }
    PG8_WAIT_V(0);
    if constexpr (!ALIGN_EPI) { if (wr == 0) PG8_BAR; }
    PG8_BAR;
    if constexpr (Epi::AFTER_DRAIN) { E.fused(acc, cur, wr, wc, fr, fq, lds, wid, lane); S.done(cur); }
#undef PG8_SA
#undef PG8_SB
#undef PG8_STAGE
#undef PG8_LDA
#undef PG8_LDB
#undef PG8_MMA
#undef PG8_WAIT_V
#undef PG8_WAIT_L
#undef PG8_BAR
#undef PG8_SCHED
}
}
namespace att {
typedef unsigned short bf16;
constexpr int NW = 8, QBLK = 32, KVBLK = 64;
constexpr float SCALE = 0.07216878364870323f;
constexpr float THR = 8.f;
constexpr int LDQ = 768, LDKN = 1024, LDKR = 64, LDV = 1024, LDO = 1024;
constexpr int SHM_V = KVBLK * 128 * 2, SHM_K = KVBLK * 192 * 2, QS_OFF = 3 * SHM_V + 3 * SHM_K + NW * 64 * 4, ATTN_LDS = QS_OFF + 512 * 4 * 16;
using bf16x8 = __attribute__((ext_vector_type(8))) short;
using s16x4  = __attribute__((ext_vector_type(4))) short;
using f32x16 = __attribute__((ext_vector_type(16))) float;
using f32x8  = __attribute__((ext_vector_type(8))) float;
using u32x4  = __attribute__((ext_vector_type(4))) unsigned;
#define KSWZ(row, colB) ((row) * 384 + ((colB) ^ ((((row) >> 1) & 7) << 4)))
#define SBAR() __builtin_amdgcn_sched_barrier(0)
__device__ __forceinline__ int crow(int r, int hi) { return (r & 3) + 8 * (r >> 2) + 4 * hi; }
__device__ __forceinline__ unsigned cvtpk(float lo, float hi) {
  unsigned r; asm volatile("v_cvt_pk_bf16_f32 %0, %1, %2" : "=v"(r) : "v"(lo), "v"(hi)); return r;
}
__device__ __forceinline__ void partialSM(f32x16& p0, f32x16& p1, float& m_reg, float& mn, float& alpha) {
  constexpr float C = SCALE * 1.4426950408889634f;
  float pmax = p0[0]; for (int r = 1; r < 16; ++r) pmax = fmaxf(pmax, p0[r]); for (int r = 0; r < 16; ++r) pmax = fmaxf(pmax, p1[r]);
  { auto rr = __builtin_amdgcn_permlane32_swap(__float_as_uint(pmax), __float_as_uint(pmax), false, false);
    pmax = fmaxf(__uint_as_float(rr[0]), __uint_as_float(rr[1])); }
  if (__builtin_expect(__all(pmax - m_reg <= THR / SCALE), 1)) { mn = m_reg; alpha = 1.f; }
  else { mn = fmaxf(m_reg, pmax); alpha = __builtin_amdgcn_exp2f((m_reg - mn) * C); m_reg = mn; }
  float mnC = -mn * C;
  for (int r = 0; r < 16; ++r) p0[r] = fmaf(p0[r], C, mnC); for (int r = 0; r < 16; ++r) p1[r] = fmaf(p1[r], C, mnC);
  for (int r = 0; r < 16; ++r) p0[r] = __builtin_amdgcn_exp2f(p0[r]);
}
__device__ __forceinline__ void finishSM(f32x16& p0, f32x16& p1, float alpha, float& l_reg, bf16x8& pa0, bf16x8& pa1, bf16x8& pa2, bf16x8& pa3) {
  for (int r = 0; r < 16; ++r) p1[r] = __builtin_amdgcn_exp2f(p1[r]);
  float ps = 0; for (int r = 0; r < 16; ++r) ps += p0[r]; for (int r = 0; r < 16; ++r) ps += p1[r];
  { auto rr = __builtin_amdgcn_permlane32_swap(__float_as_uint(ps), __float_as_uint(ps), false, false);
    ps = __uint_as_float(rr[0]) + __uint_as_float(rr[1]); }
  l_reg = l_reg * alpha + ps;
#define PK4(P, BASE, OUT) do { unsigned a0 = cvtpk(P[BASE + 0], P[BASE + 1]), a1 = cvtpk(P[BASE + 2], P[BASE + 3]);   \
    unsigned b0 = cvtpk(P[BASE + 4], P[BASE + 5]), b1 = cvtpk(P[BASE + 6], P[BASE + 7]);                              \
    auto r0 = __builtin_amdgcn_permlane32_swap(a0, b0, false, false); auto r1 = __builtin_amdgcn_permlane32_swap(a1, b1, false, false); \
    u32x4 w = {r0[0], r1[0], r0[1], r1[1]}; OUT = *reinterpret_cast<bf16x8*>(&w); } while (0)
  PK4(p0, 0, pa0); PK4(p0, 8, pa1); PK4(p1, 0, pa2); PK4(p1, 8, pa3);
#undef PK4
}
__device__ __forceinline__ int v_st(int k, int c) { const int kk = (k & ~0xC) | ((k & 4) << 1) | ((k & 8) >> 1); return ((kk >> 3) * 4 + (c >> 5)) * 512 + ((kk & 7) * 32 + (c & 31)) * 2; }
__device__ __forceinline__ int v_rd_base(int lane) { return ((lane & 3) << 3) | (((lane >> 2) & 3) << 6) | (((lane >> 4) & 1) << 5) | (((lane >> 5) & 1) << 8); }
constexpr int v_rd_off(int d0, int ks, int half) { return d0 * 512 + ks * 4096 + half * 2048; }
template <int OFF> __device__ __forceinline__ s16x4 tr_read(int vb) {
  s16x4 r; asm volatile("ds_read_b64_tr_b16 %0, %1 offset:%2" : "=&v"(r) : "v"(vb), "i"(OFF) : "memory"); return r;
}
template <int D0> __device__ __forceinline__ void pv_one(f32x16& od, int vb, bf16x8 pa0, bf16x8 pa1, bf16x8 pa2, bf16x8 pa3) {
  const s16x4 l0 = tr_read<v_rd_off(D0, 0, 0)>(vb), h0 = tr_read<v_rd_off(D0, 0, 1)>(vb), l1 = tr_read<v_rd_off(D0, 1, 0)>(vb), h1 = tr_read<v_rd_off(D0, 1, 1)>(vb);
  const s16x4 l2 = tr_read<v_rd_off(D0, 2, 0)>(vb), h2 = tr_read<v_rd_off(D0, 2, 1)>(vb), l3 = tr_read<v_rd_off(D0, 3, 0)>(vb), h3 = tr_read<v_rd_off(D0, 3, 1)>(vb);
  asm volatile("s_waitcnt lgkmcnt(0)" ::: "memory"); SBAR();
#define PK(L, H) (bf16x8){L[0], L[1], L[2], L[3], H[0], H[1], H[2], H[3]}
  od = __builtin_amdgcn_mfma_f32_32x32x16_bf16(pa0, PK(l0, h0), od, 0, 0, 0);
  od = __builtin_amdgcn_mfma_f32_32x32x16_bf16(pa1, PK(l1, h1), od, 0, 0, 0);
  od = __builtin_amdgcn_mfma_f32_32x32x16_bf16(pa2, PK(l2, h2), od, 0, 0, 0);
  od = __builtin_amdgcn_mfma_f32_32x32x16_bf16(pa3, PK(l3, h3), od, 0, 0, 0);
#undef PK
}
template <int D0> __device__ __forceinline__ void pv_rd(s16x4 (&f)[8], int vb) {
  f[0] = tr_read<v_rd_off(D0, 0, 0)>(vb); f[1] = tr_read<v_rd_off(D0, 0, 1)>(vb); f[2] = tr_read<v_rd_off(D0, 1, 0)>(vb); f[3] = tr_read<v_rd_off(D0, 1, 1)>(vb);
  f[4] = tr_read<v_rd_off(D0, 2, 0)>(vb); f[5] = tr_read<v_rd_off(D0, 2, 1)>(vb); f[6] = tr_read<v_rd_off(D0, 3, 0)>(vb); f[7] = tr_read<v_rd_off(D0, 3, 1)>(vb);
}
__device__ __forceinline__ void pv_mm(f32x16& od, const s16x4 (&f)[8], bf16x8 pa0, bf16x8 pa1, bf16x8 pa2, bf16x8 pa3) {
#define PK(L, H) (bf16x8){L[0], L[1], L[2], L[3], H[0], H[1], H[2], H[3]}
  od = __builtin_amdgcn_mfma_f32_32x32x16_bf16(pa0, PK(f[0], f[1]), od, 0, 0, 0);
  od = __builtin_amdgcn_mfma_f32_32x32x16_bf16(pa1, PK(f[2], f[3]), od, 0, 0, 0);
  od = __builtin_amdgcn_mfma_f32_32x32x16_bf16(pa2, PK(f[4], f[5]), od, 0, 0, 0);
  od = __builtin_amdgcn_mfma_f32_32x32x16_bf16(pa3, PK(f[6], f[7]), od, 0, 0, 0);
#undef PK
}
#define PV_WAIT(n, f) asm volatile("s_waitcnt lgkmcnt(" #n ")" : "+v"(f[0]), "+v"(f[1]), "+v"(f[2]), "+v"(f[3]), "+v"(f[4]), "+v"(f[5]), "+v"(f[6]), "+v"(f[7]) :: "memory")
__device__ __forceinline__ void pv_d0(f32x16* o, int vb, bf16x8 pa0, bf16x8 pa1, bf16x8 pa2, bf16x8 pa3) {
  s16x4 fa[8], fb[8];
  pv_rd<0>(fa, vb); pv_rd<1>(fb, vb);
  PV_WAIT(8, fa); pv_mm(o[0], fa, pa0, pa1, pa2, pa3);
  pv_rd<2>(fa, vb);
  PV_WAIT(8, fb); pv_mm(o[1], fb, pa0, pa1, pa2, pa3);
  pv_rd<3>(fb, vb);
  PV_WAIT(8, fa); pv_mm(o[2], fa, pa0, pa1, pa2, pa3);
  PV_WAIT(0, fb); pv_mm(o[3], fb, pa0, pa1, pa2, pa3);
}
#undef PV_WAIT
__device__ __forceinline__ void qkt(f32x16& p0, f32x16& p1, const char* Ks, const bf16x8* qr, const bf16x8* qs, const int* kb) {
  p0 = f32x16{}; p1 = f32x16{};
#pragma unroll
  for (int d0 = 0; d0 < 12; ++d0) { const int off = kb[d0 & 3] + (d0 >> 2) * 128;
    bf16x8 b0 = *reinterpret_cast<const bf16x8*>(Ks + off);
    bf16x8 b1 = *reinterpret_cast<const bf16x8*>(Ks + off + 32 * 384);
    const bf16x8 q = d0 < 8 ? qr[d0 < 8 ? d0 : 0] : qs[(d0 - 8) * 64];
    p0 = __builtin_amdgcn_mfma_f32_32x32x16_bf16(b0, q, p0, 0, 0, 0);
    p1 = __builtin_amdgcn_mfma_f32_32x32x16_bf16(b1, q, p1, 0, 0, 0); }
}
__device__ __forceinline__ unsigned short f2bf16(float f) { unsigned u = __builtin_bit_cast(unsigned, f); return (unsigned short)((u + 0x7fffu + ((u >> 16) & 1u)) >> 16); }
__device__ __forceinline__ void attn_unit(const bf16* __restrict__ Qb, const bf16* __restrict__ KN, const bf16* __restrict__ KR,
                                          bf16* __restrict__ Ob, int lat0, int nlat, int ctx0, int seq, char* lds,
                                          const float* __restrict__ qn_g, const float* __restrict__ qr_g, const float* __restrict__ rope, int npos0) {
  const int tid = tidx(), wid = tid >> 6, lane = tid & 63, r32 = lane & 31, hi = lane >> 5;
  char* V_lds = lds; char* K_lds = lds + 3 * SHM_V;
  float* ws = (float*)(lds + 3 * SHM_V + 3 * SHM_K) + wid * 64; float* li_l = ws; float* al_l = ws + 32;
  float m_reg = -1e30f, l_reg = 0; f32x16 o[4] = {}; bf16x8 qr[8];
  bf16x8* qs = (bf16x8*)(lds + QS_OFF) + wid * 4 * 64 + lane;
  const bf16* Qw = Qb + (long)(wid * QBLK + r32) * LDQ + hi * 8;
  {
    bf16x8 raw[12];
#pragma unroll
    for (int d0 = 0; d0 < 12; ++d0) raw[d0] = *reinterpret_cast<const bf16x8*>(Qw + d0 * 16);
    float ssn = 0.f, ssr = 0.f;
#pragma unroll
    for (int d0 = 0; d0 < 12; ++d0)
#pragma unroll
      for (int e = 0; e < 8; ++e) { const float v = __builtin_bit_cast(float, ((unsigned)(unsigned short)raw[d0][e]) << 16); if (d0 < 8) ssn += v * v; else ssr += v * v; }
    ssn += __shfl_xor(ssn, 32); ssr += __shfl_xor(ssr, 32);
    const float rsn = 1.0f / sqrtf(ssn * (1.0f / 128) + 1e-6f), rsr = 1.0f / sqrtf(ssr * (1.0f / 64) + 1e-6f);
#pragma unroll
    for (int d0 = 0; d0 < 8; ++d0) { u32x4 w;
#pragma unroll
      for (int e2 = 0; e2 < 4; ++e2) { const int d = d0 * 16 + hi * 8 + 2 * e2;
        const float v0 = __builtin_bit_cast(float, ((unsigned)(unsigned short)raw[d0][2 * e2]) << 16) * rsn * qn_g[d], v1 = __builtin_bit_cast(float, ((unsigned)(unsigned short)raw[d0][2 * e2 + 1]) << 16) * rsn * qn_g[d + 1];
        w[e2] = cvtpk(v0, v1); }
      qr[d0] = *reinterpret_cast<bf16x8*>(&w); }
    const int npos = npos0 < 0 ? -1 : npos0 + wid * QBLK + r32;
#pragma unroll
    for (int a = 0; a < 2; ++a) { u32x4 w0, w1; const int pos = a ? (npos & 63) : (npos >> 6);
#pragma unroll
      for (int e2 = 0; e2 < 4; ++e2) { float o0[2], o1[2];
#pragma unroll
        for (int t = 0; t < 2; ++t) { const int e = 2 * e2 + t, f = hi * 8 + e;
          const float x0 = __builtin_bit_cast(float, ((unsigned)(unsigned short)raw[8 + 2 * a][e]) << 16) * rsr * qr_g[a * 32 + f];
          const float x1 = __builtin_bit_cast(float, ((unsigned)(unsigned short)raw[9 + 2 * a][e]) << 16) * rsr * qr_g[a * 32 + 16 + f];
          float c = 1.f, sn = 0.f; if (npos >= 0) { c = rope[(pos * 16 + f) * 2]; sn = rope[(pos * 16 + f) * 2 + 1]; }
          o0[t] = x0 * c - x1 * sn; o1[t] = x1 * c + x0 * sn; }
        w0[e2] = cvtpk(o0[0], o0[1]); w1[e2] = cvtpk(o1[0], o1[1]); }
      qs[(2 * a) * 64] = *reinterpret_cast<bf16x8*>(&w0); qs[(2 * a + 1) * 64] = *reinterpret_cast<bf16x8*>(&w1); }
  }
  int kb[4];
#pragma unroll
  for (int j = 0; j < 4; ++j) kb[j] = r32 * 384 + ((j * 32 + hi * 16) ^ (((r32 >> 1) & 7) << 4));
  const int sr = tid >> 4, sc = (tid & 15) * 8, vst0 = v_st(sr, sc), vst1 = v_st(32 + sr, sc);
  const int knd0 = KSWZ(sr, sc * 2), knd1 = knd0 + 32 * 384, krd = KSWZ(tid >> 3, (16 + (tid & 7)) * 16);
  const int vb0 = (int)(uintptr_t)V_lds + v_rd_base(lane);
  bf16x8 vs0, vs1, ks0, ks1, ks2;
#define KROW(k0) (((k0) < nlat) ? lat0 + (k0) : ctx0 + (k0) - nlat)
#define SLOAD(k0) do { const long rb = KROW(k0); const bf16* pn = KN + (rb + sr) * LDKN + sc; \
    ks0 = *reinterpret_cast<const bf16x8*>(pn); ks1 = *reinterpret_cast<const bf16x8*>(pn + 32 * LDKN); vs0 = *reinterpret_cast<const bf16x8*>(pn + 128); vs1 = *reinterpret_cast<const bf16x8*>(pn + 32 * LDKN + 128); \
    ks2 = *reinterpret_cast<const bf16x8*>(KR + rb * LDKR + tid * 8); } while (0)
#define SWRITE(b) do { *(bf16x8*)(V_lds + (b) * SHM_V + vst0) = vs0; *(bf16x8*)(V_lds + (b) * SHM_V + vst1) = vs1; \
    *(bf16x8*)(K_lds + (b) * SHM_K + knd0) = ks0; *(bf16x8*)(K_lds + (b) * SHM_K + knd1) = ks1; *(bf16x8*)(K_lds + (b) * SHM_K + krd) = ks2; } while (0)
#define SWAIT() asm volatile("s_waitcnt vmcnt(0)" ::: "memory")
#define RESC(a) do { if (__any((a) < 1.f)) { if (hi == 0) al_l[r32] = (a); asm volatile("s_waitcnt lgkmcnt(0)" ::: "memory"); \
    for (int d = 0; d < 4; ++d) for (int r = 0; r < 16; ++r) o[d][r] *= al_l[crow(r, hi)]; } } while (0)
  f32x16 pA0, pA1, pB0, pB1; float mnA, mnB, alA, alB; bf16x8 pa0, pa1, pa2, pa3; const int NT = seq / KVBLK;
  SLOAD(0); SWAIT(); SWRITE(0); __syncthreads();
  qkt(pA0, pA1, K_lds, qr, qs, kb); partialSM(pA0, pA1, m_reg, mnA, alA);
  SLOAD(KVBLK); SWAIT(); SWRITE(1); __syncthreads();
  int rp = 0, rc = 1, rn = 2;
  for (int j = 1; j + 1 < NT; j += 2) {
    SBAR(); qkt(pB0, pB1, K_lds + rc * SHM_K, qr, qs, kb);
    finishSM(pA0, pA1, alA, l_reg, pa0, pa1, pa2, pa3); SBAR();
    SLOAD((j + 1) * KVBLK); SBAR();
    pv_d0(o, vb0 + rp * SHM_V, pa0, pa1, pa2, pa3); partialSM(pB0, pB1, m_reg, mnB, alB);
    SWAIT(); SWRITE(rn);
    RESC(alB); __syncthreads();
    { const int t = rp; rp = rc; rc = rn; rn = t; }
    SBAR(); qkt(pA0, pA1, K_lds + rc * SHM_K, qr, qs, kb);
    finishSM(pB0, pB1, alB, l_reg, pa0, pa1, pa2, pa3); SBAR();
    SLOAD((j + 2) * KVBLK); SBAR();
    pv_d0(o, vb0 + rp * SHM_V, pa0, pa1, pa2, pa3); partialSM(pA0, pA1, m_reg, mnA, alA);
    SWAIT(); SWRITE(rn);
    RESC(alA); __syncthreads();
    { const int t = rp; rp = rc; rc = rn; rn = t; }
  }
  SBAR(); qkt(pB0, pB1, K_lds + rc * SHM_K, qr, qs, kb);
  finishSM(pA0, pA1, alA, l_reg, pa0, pa1, pa2, pa3); SBAR();
  pv_d0(o, vb0 + rp * SHM_V, pa0, pa1, pa2, pa3); partialSM(pB0, pB1, m_reg, mnB, alB);
  RESC(alB);
  finishSM(pB0, pB1, alB, l_reg, pa0, pa1, pa2, pa3); SBAR();
  pv_d0(o, vb0 + rc * SHM_V, pa0, pa1, pa2, pa3);
  if (hi == 0) li_l[r32] = l_reg; asm volatile("s_waitcnt lgkmcnt(0)" ::: "memory");
  float rli[16];
#pragma unroll
  for (int r = 0; r < 16; ++r) rli[r] = __builtin_amdgcn_rcpf(li_l[crow(r, hi)]);
  bf16* Ow = Ob + (long)(wid * QBLK) * LDO;
#pragma unroll
  for (int r = 0; r < 16; ++r) { const int orow = crow(r, hi);
#pragma unroll
    for (int d0 = 0; d0 < 4; ++d0) Ow[(long)orow * LDO + d0 * 32 + r32] = f2bf16(o[d0][r] * rli[r]); }
#undef KROW
#undef SLOAD
#undef SWRITE
#undef SWAIT
#undef RESC
}
#undef SBAR
#undef KSWZ
}
#define LAS __attribute__((address_space(3)))
typedef unsigned short bf16;
typedef unsigned v4u __attribute__((ext_vector_type(4)));
typedef unsigned v2u __attribute__((ext_vector_type(2)));
typedef float f32x4 __attribute__((ext_vector_type(4)));
constexpr size_t MiB = 1u << 20;
constexpr size_t WS_MOD = 0, WS_ROPE = 1 * MiB, WS_XC = 2 * MiB, WS_W = 6 * MiB, WS_H = 96 * MiB, WS_Y = 162 * MiB, WS_QL = 261 * MiB, WS_KVL = 278 * MiB,
                 WS_Q = 287 * MiB, WS_KV = 337 * MiB, WS_KR = 403 * MiB, WS_MIX = 408 * MiB, WS_EDGE = 408 * MiB, WS_HID = 162 * MiB, WS_END = 506 * MiB;
constexpr size_t WO_IN = 0, WO_Q = WO_IN + (size_t)INP * DM, WO_KV = WO_Q + (size_t)768 * QRK, WO_O = WO_KV + (size_t)1024 * KVRK, WO_UP = WO_O + (size_t)DM * DM,
                 WO_DN = WO_UP + (size_t)2 * DFF * DM, W_LAYER = WO_DN + (size_t)DM * DFF;
static_assert(WS_W + W_LAYER * 2 * DEPTH <= WS_H && WS_H + (size_t)TT * DM * 2 <= WS_Y && WS_Y + (size_t)TT * INP * 2 <= WS_QL && WS_QL + (size_t)TT * QRK * 2 <= WS_KVL &&
              WS_KVL + (size_t)TT * KVRK * 2 <= WS_Q && WS_Q + (size_t)TT * 768 * 2 <= WS_KV && WS_KV + (size_t)TT * 1024 * 2 <= WS_KR && WS_KR + (size_t)TT * 64 * 2 <= WS_MIX &&
              WS_MIX + (size_t)TT * DM * 2 <= 474 * MiB && WS_EDGE + (size_t)3 * (TT / 64) * 2 * DFF * 4 <= 474 * MiB && WS_HID + (size_t)TT * DFF * 2 <= WS_KR, "d_ws map");
constexpr size_t WS_PART_WO = 344 * MiB;
constexpr size_t WS_PART_DN = 408 * MiB;
constexpr size_t WS_X1A = 376 * MiB, WS_X1B = 474 * MiB;
constexpr int X1_SPLIT = 16384;
static_assert(WS_PART_WO >= WS_HID + (size_t)TT * DFF * 2 && WS_PART_WO + (size_t)8 * TCTX * DM * 4 <= WS_X1A && WS_X1A + (size_t)X1_SPLIT * DM * 2 <= WS_MIX &&
              WS_PART_DN + (size_t)11 * TCTX * DM * 4 <= 474 * MiB && WS_X1B + (size_t)(TLAT - X1_SPLIT) * DM * 2 <= WS_END, "slabs and x1 map");
constexpr size_t EDGE_N = (size_t)(TT / 64) * 2 * DFF;
constexpr int LDS_BYTES = 163840, LDS_ST_OFF = LDS_BYTES - 64;
constexpr size_t WS_BAR = WS_ROPE + 512 * 1024;
constexpr int NPH = 1 + 10 * DEPTH;
constexpr int NCTXU = (TCTX / 256) * (INP / 256);
static_assert(att::ATTN_LDS <= LDS_ST_OFF, "attention LDS map below the barrier words");

__device__ __forceinline__ unsigned f2bf(float f) { unsigned u = __builtin_bit_cast(unsigned, f); return (u + 0x7fffu + ((u >> 16) & 1u)) >> 16; }
__device__ __forceinline__ unsigned pk2(float lo, float hi) { typedef float f32x2_c __attribute__((ext_vector_type(2))); typedef __bf16 bf16x2_c __attribute__((ext_vector_type(2)));
    const f32x2_c v = {lo, hi}; const bf16x2_c b = __builtin_convertvector(v, bf16x2_c); return __builtin_bit_cast(unsigned, b); }
__device__ __forceinline__ float bflo(unsigned w) { return __builtin_bit_cast(float, w << 16); }
__device__ __forceinline__ float bfhi(unsigned w) { return __builtin_bit_cast(float, w & 0xffff0000u); }
__device__ __forceinline__ float wave_sum(float v) {
    v += __builtin_bit_cast(float, __builtin_amdgcn_update_dpp(0, __builtin_bit_cast(int, v), 0xB1, 0xF, 0xF, true));
    v += __builtin_bit_cast(float, __builtin_amdgcn_update_dpp(0, __builtin_bit_cast(int, v), 0x4E, 0xF, 0xF, true));
    v += __builtin_bit_cast(float, __builtin_amdgcn_update_dpp(0, __builtin_bit_cast(int, v), 0x141, 0xF, 0xF, true));
    v += __builtin_bit_cast(float, __builtin_amdgcn_update_dpp(0, __builtin_bit_cast(int, v), 0x140, 0xF, 0xF, true));
    const float r0 = __builtin_bit_cast(float, __builtin_amdgcn_readlane(__builtin_bit_cast(int, v), 0)), r1 = __builtin_bit_cast(float, __builtin_amdgcn_readlane(__builtin_bit_cast(int, v), 16));
    const float r2 = __builtin_bit_cast(float, __builtin_amdgcn_readlane(__builtin_bit_cast(int, v), 32)), r3 = __builtin_bit_cast(float, __builtin_amdgcn_readlane(__builtin_bit_cast(int, v), 48));
    v = (r0 + r1) + (r2 + r3);
    return v;
}
#define LDS_WAIT() asm volatile("s_waitcnt lgkmcnt(0)" ::: "memory")

#define XB_TMO      128
#define XB_XCNT(j)  (256  + 64 * (j))
#define XB_XSUB(j)  (1280 + 64 * (j))
#define XB_XGEN(j)  (2304 + 64 * (j))
#define XB_TOP      3328
#define XB_TOPGEN   3392
#define XCD_BAR_WORDS 3456
#define XB_SPIN_CAP (1u << 18)

__device__ __forceinline__ unsigned xb_ld(unsigned* p)              { return __hip_atomic_load(p, __ATOMIC_RELAXED, __HIP_MEMORY_SCOPE_AGENT); }
__device__ __forceinline__ unsigned xb_add(unsigned* p, unsigned v) { return __hip_atomic_fetch_add(p, v, __ATOMIC_RELAXED, __HIP_MEMORY_SCOPE_AGENT); }
__device__ __forceinline__ unsigned xb_xcc_id() { return (unsigned)__builtin_amdgcn_s_getreg((3 << 11) | 20) & 0xFu; }
#define XB_SPIN(cond, bar) do { unsigned _sp = 0; while (cond) { __builtin_amdgcn_s_sleep(1); \
    if ((++_sp & 255u) == 0u) { if (xb_ld(&(bar)[XB_TMO])) break; if (_sp > XB_SPIN_CAP) { atomicAdd(&(bar)[XB_TMO], 1u); break; } } } } while (0)

struct XcdBarrier {
    unsigned* bar; unsigned x;
    volatile LAS unsigned* st;
};

__device__ __forceinline__ XcdBarrier xcd_barrier_post(unsigned* bar, volatile LAS unsigned* st) {
    XcdBarrier b; b.bar = bar; b.x = xb_xcc_id(); b.st = st;
    if (tidx() == 0) (void)xb_add(&bar[XB_XCNT(b.x)], 1u);
    return b;
}
__device__ __forceinline__ void xcd_barrier_complete(unsigned* bar, unsigned x, unsigned& nloc, unsigned& nx) {
    const unsigned G = gridDim.x * gridDim.y * gridDim.z;
    unsigned sum, cnt, mine, sp = 0u;
    for (;;) {
        sum = 0u; cnt = 0u; mine = 0u;
#pragma unroll
        for (unsigned j = 0; j < 16; ++j) { const unsigned c = xb_ld(&bar[XB_XCNT(j)]); sum += c; cnt += (c > 0u) ? 1u : 0u; mine = (j == x) ? c : mine; }
        if (sum == G) break;
        __builtin_amdgcn_s_sleep(1);
        if ((++sp & 255u) == 0u) { if (xb_ld(&bar[XB_TMO])) break; if (sp > XB_SPIN_CAP) { atomicAdd(&bar[XB_TMO], 1u); break; } }
    }
    nloc = mine > 0u ? mine : 1u; nx = cnt > 0u ? cnt : 1u;
}

__device__ __forceinline__ void xcd_barrier(const XcdBarrier& b) {
    asm volatile("s_waitcnt vmcnt(0)" ::: "memory");
    __syncthreads();
    if (tidx() == 0) {
        unsigned* bar = b.bar;
        __builtin_amdgcn_s_waitcnt(0);
        unsigned nloc = b.st[0], nx = b.st[1];
        if (nloc == 0u) { xcd_barrier_complete(bar, b.x, nloc, nx); b.st[0] = nloc; b.st[1] = nx; }
        const unsigned old = xb_add(&bar[XB_XSUB(b.x)], 1u);
        const unsigned gen = old / nloc;
        if (old + 1u == (gen + 1u) * nloc) {
            __builtin_amdgcn_fence(__ATOMIC_RELEASE, "agent");
            asm volatile("s_waitcnt vmcnt(0)" ::: "memory");
            const unsigned og = xb_add(&bar[XB_TOP], 1u);
            const unsigned tg = og / nx;
            if (og + 1u == (tg + 1u) * nx) xb_add(&bar[XB_TOPGEN], 1u);
            else XB_SPIN(xb_ld(&bar[XB_TOPGEN]) == tg, bar);
            __builtin_amdgcn_fence(__ATOMIC_ACQUIRE, "agent");
            xb_add(&bar[XB_XGEN(b.x)], 1u);
            asm volatile("s_waitcnt vmcnt(0)" ::: "memory");
        } else {
            XB_SPIN(xb_ld(&bar[XB_XGEN(b.x)]) == gen, bar);
            __builtin_amdgcn_fence(__ATOMIC_ACQUIRE, "agent");
            asm volatile("s_waitcnt vmcnt(0)" ::: "memory");
        }
    }
    __syncthreads();
}

struct Params { const float* in[24]; float* out; unsigned char* ws; int ph_lo, ph_hi; };
typedef const Params __attribute__((address_space(4))) CParams;
namespace pg8 {
__device__ __forceinline__ unsigned f2bf(float f) { unsigned u = __builtin_bit_cast(unsigned, f); return (u + 0x7fffu + ((u >> 16) & 1u)) >> 16; }
__device__ __forceinline__ unsigned pk2(float lo, float hi) { typedef float f32x2_c __attribute__((ext_vector_type(2))); typedef __bf16 bf16x2_c __attribute__((ext_vector_type(2)));
    const f32x2_c v = {lo, hi}; const bf16x2_c b = __builtin_convertvector(v, bf16x2_c); return __builtin_bit_cast(unsigned, b); }
struct EpiStore {
    static constexpr bool PERM = true, AFTER_DRAIN = false;
    bf16_t* O; int ldc;
    __device__ __forceinline__ void operator()(const f32x4 (&acc)[2][2][4][2], const Unit& u, int wr, int wc, int fr, int fq) const {
        const int row0 = u.pm * BM + wr * 64 + fr, col0 = u.pn * BM + wc * 32 + 8 * fq;
#pragma unroll
        for (int ai = 0; ai < 2; ++ai)
#pragma unroll
            for (int m = 0; m < 4; ++m) { bf16_t* rowp = O + (size_t)(row0 + ai * HALF + m * 16) * ldc + col0;
#pragma unroll
                for (int bj = 0; bj < 2; ++bj) { const f32x4 v0 = acc[ai][bj][m][0], v1 = acc[ai][bj][m][1];
                    u32x4 w; w.x = pk2(v0[0], v0[1]); w.y = pk2(v0[2], v0[3]); w.z = pk2(v1[0], v1[1]); w.w = pk2(v1[2], v1[3]);
                    *(u32x4*)(rowp + bj * HALF) = w; } }
    }
};
struct EpiKv {
    static constexpr bool PERM = true, AFTER_DRAIN = false;
    bf16_t* O; const float* kn_g; __attribute__((address_space(3))) float* X;
    __device__ __forceinline__ void operator()(const f32x4 (&acc)[2][2][4][2], const Unit& u, int wr, int wc, int fr, int fq) const {
        const int row0 = u.pm * BM + wr * 64 + fr, col0 = u.pn * BM + wc * 32 + 8 * fq;
        float ss[2][4];
#pragma unroll
        for (int ai = 0; ai < 2; ++ai)
#pragma unroll
            for (int m = 0; m < 4; ++m) { const f32x4 a = acc[ai][0][m][0], b = acc[ai][0][m][1];
                float s = ((a[0] * a[0] + a[1] * a[1]) + (a[2] * a[2] + a[3] * a[3])) + ((b[0] * b[0] + b[1] * b[1]) + (b[2] * b[2] + b[3] * b[3]));
                s += __shfl_xor(s, 16); s += __shfl_xor(s, 32);
                ss[ai][m] = s; }
        if (fq == 0) {
#pragma unroll
            for (int ai = 0; ai < 2; ++ai)
#pragma unroll
                for (int m = 0; m < 4; ++m) X[(ai * HALF + wr * 64 + m * 16 + fr) * 4 + wc] = ss[ai][m]; }
        asm volatile("s_waitcnt lgkmcnt(0)" ::: "memory"); __builtin_amdgcn_s_barrier(); asm volatile("" ::: "memory");
        const f32x4 g0 = *(const f32x4*)(kn_g + wc * 32 + 8 * fq), g1 = *(const f32x4*)(kn_g + wc * 32 + 8 * fq + 4);
#pragma unroll
        for (int ai = 0; ai < 2; ++ai)
#pragma unroll
            for (int m = 0; m < 4; ++m) { bf16_t* rowp = O + (size_t)(row0 + ai * HALF + m * 16) * 1024 + col0;
                const f32x4 xp = *(const __attribute__((address_space(3))) f32x4*)(X + (ai * HALF + wr * 64 + m * 16 + fr) * 4);
                const float rs = 1.0f / sqrtf(((xp[0] + xp[1]) + (xp[2] + xp[3])) * (1.0f / 128) + EPSN);
                { const f32x4 v0 = acc[ai][0][m][0] * rs * g0, v1 = acc[ai][0][m][1] * rs * g1;
                  u32x4 w; w.x = pk2(v0[0], v0[1]); w.y = pk2(v0[2], v0[3]); w.z = pk2(v1[0], v1[1]); w.w = pk2(v1[2], v1[3]); *(u32x4*)(rowp) = w; }
                { const f32x4 v0 = acc[ai][1][m][0], v1 = acc[ai][1][m][1];
                  u32x4 w; w.x = pk2(v0[0], v0[1]); w.y = pk2(v0[2], v0[3]); w.z = pk2(v1[0], v1[1]); w.w = pk2(v1[2], v1[3]); *(u32x4*)(rowp + HALF) = w; } }
    }
};
struct EpiIn {
    static constexpr bool PERM = true, AFTER_DRAIN = false;
    unsigned char* ws; const float* qc_g; const float* kvc_g; const float* kr_g; __attribute__((address_space(3))) float* X;
    __device__ __forceinline__ void operator()(const f32x4 (&acc)[2][2][4][2], const Unit& u, int wr, int wc, int fr, int fq) const {
        bf16_t* Y = (bf16_t*)(ws + WS_Y);
        const int row0 = u.pm * BM + wr * 64 + fr;
        if (u.pn >= 2) { EpiStore E{Y, INP}; E(acc, u, wr, wc, fr, fq); return; }
#pragma unroll
        for (int ai = 0; ai < 2; ++ai)
#pragma unroll
            for (int m = 0; m < 4; ++m) {
                float s[2];
#pragma unroll
                for (int bj = 0; bj < 2; ++bj) { const f32x4 a = acc[ai][bj][m][0], b = acc[ai][bj][m][1];
                    float t = ((a[0] * a[0] + a[1] * a[1]) + (a[2] * a[2] + a[3] * a[3])) + ((b[0] * b[0] + b[1] * b[1]) + (b[2] * b[2] + b[3] * b[3]));
                    t += __shfl_xor(t, 16); t += __shfl_xor(t, 32); s[bj] = t; }
                if (fq == 0) { const int xr = (ai * HALF + wr * 64 + m * 16 + fr) * 8; X[xr + wc] = s[0]; X[xr + 4 + wc] = s[1]; } }
        asm volatile("s_waitcnt lgkmcnt(0)" ::: "memory"); __builtin_amdgcn_s_barrier(); asm volatile("" ::: "memory");
        const int c8 = wc * 32 + 8 * fq;
        if (u.pn == 0) {
            bf16_t* QLp = (bf16_t*)(ws + WS_QL);
            f32x4 g[2][2];
#pragma unroll
            for (int bj = 0; bj < 2; ++bj) { g[bj][0] = *(const f32x4*)(qc_g + bj * HALF + c8); g[bj][1] = *(const f32x4*)(qc_g + bj * HALF + c8 + 4); }
#pragma unroll
            for (int ai = 0; ai < 2; ++ai)
#pragma unroll
                for (int m = 0; m < 4; ++m) { const int lr = ai * HALF + wr * 64 + m * 16 + fr;
                    const f32x4 xa = *(const __attribute__((address_space(3))) f32x4*)(X + lr * 8), xb = *(const __attribute__((address_space(3))) f32x4*)(X + lr * 8 + 4);
                    const float rs = 1.0f / sqrtf((((xa[0] + xa[1]) + (xa[2] + xa[3])) + ((xb[0] + xb[1]) + (xb[2] + xb[3]))) * (1.0f / QRK) + EPSN);
                    bf16_t* rowp = QLp + (size_t)(row0 + ai * HALF + m * 16) * QRK + c8;
#pragma unroll
                    for (int bj = 0; bj < 2; ++bj) { const f32x4 v0 = acc[ai][bj][m][0] * rs * g[bj][0], v1 = acc[ai][bj][m][1] * rs * g[bj][1];
                        u32x4 w; w.x = pk2(v0[0], v0[1]); w.y = pk2(v0[2], v0[3]); w.z = pk2(v1[0], v1[1]); w.w = pk2(v1[2], v1[3]); *(u32x4*)(rowp + bj * HALF) = w; } }
        } else {
            bf16_t* KVLp = (bf16_t*)(ws + WS_KVL); bf16_t* KRp = (bf16_t*)(ws + WS_KR); const float* rope = (const float*)(ws + WS_ROPE);
            const f32x4 gk0 = *(const f32x4*)(kvc_g + c8), gk1 = *(const f32x4*)(kvc_g + c8 + 4);
            const bool lat = u.pm * BM < TLAT;
#pragma unroll
            for (int ai = 0; ai < 2; ++ai)
#pragma unroll
                for (int m = 0; m < 4; ++m) { const int lr = ai * HALF + wr * 64 + m * 16 + fr; const int row = row0 + ai * HALF + m * 16;
                    const f32x4 xa = *(const __attribute__((address_space(3))) f32x4*)(X + lr * 8), xb = *(const __attribute__((address_space(3))) f32x4*)(X + lr * 8 + 4);
                    { const float rs = 1.0f / sqrtf(((xa[0] + xa[1]) + (xa[2] + xa[3])) * (1.0f / KVRK) + EPSN);
                      const f32x4 v0 = acc[ai][0][m][0] * rs * gk0, v1 = acc[ai][0][m][1] * rs * gk1;
                      u32x4 w; w.x = pk2(v0[0], v0[1]); w.y = pk2(v0[2], v0[3]); w.z = pk2(v1[0], v1[1]); w.w = pk2(v1[2], v1[3]); *(u32x4*)(KVLp + (size_t)row * KVRK + c8) = w; }
                    if (wc < 2) {
                        const float rs = 1.0f / sqrtf((xb[0] + xb[1]) * (1.0f / 64) + EPSN);
                        const f32x4 gr0 = *(const f32x4*)(kr_g + c8), gr1 = *(const f32x4*)(kr_g + c8 + 4);
                        f32x4 v0 = acc[ai][1][m][0] * rs * gr0, v1 = acc[ai][1][m][1] * rs * gr1;
                        f32x4 p0, p1;
#pragma unroll
                        for (int e = 0; e < 4; ++e) { p0[e] = __shfl_xor(v0[e], 32); p1[e] = __shfl_xor(v1[e], 32); }
                        if (lat) { const int n = row & (SEQ - 1); const int pos = wc ? (n & 63) : (n >> 6); const float* rt = rope + (size_t)(pos * 16 + (fq & 1) * 8) * 2; const float sg = (fq >> 1) ? 1.f : -1.f;
                            const f32x4 t0 = *(const f32x4*)(rt), t1 = *(const f32x4*)(rt + 4), t2 = *(const f32x4*)(rt + 8), t3 = *(const f32x4*)(rt + 12);
                            v0 = (f32x4){v0[0] * t0[0] + sg * p0[0] * t0[1], v0[1] * t0[2] + sg * p0[1] * t0[3], v0[2] * t1[0] + sg * p0[2] * t1[1], v0[3] * t1[2] + sg * p0[3] * t1[3]};
                            v1 = (f32x4){v1[0] * t2[0] + sg * p1[0] * t2[1], v1[1] * t2[2] + sg * p1[1] * t2[3], v1[2] * t3[0] + sg * p1[2] * t3[1], v1[3] * t3[2] + sg * p1[3] * t3[3]}; }
                        u32x4 w; w.x = pk2(v0[0], v0[1]); w.y = pk2(v0[2], v0[3]); w.z = pk2(v1[0], v1[1]); w.w = pk2(v1[2], v1[3]); *(u32x4*)(KRp + (size_t)row * 64 + c8) = w;
                    } else {
                        const f32x4 v0 = acc[ai][1][m][0], v1 = acc[ai][1][m][1];
                        u32x4 w; w.x = pk2(v0[0], v0[1]); w.y = pk2(v0[2], v0[3]); w.z = pk2(v1[0], v1[1]); w.w = pk2(v1[2], v1[3]); *(u32x4*)(Y + (size_t)row * INP + 384 + c8) = w; } }
        }
    }
};
struct EpiResid {
    static constexpr bool PERM = true, AFTER_DRAIN = false;
    const float* xin_lat; const float* xin_ctx; float* out_lat; float* out_ctx; const float* modL; int gate_chunk;
    bf16_t* x1a; bf16_t* x1b; int flags;
    __device__ __forceinline__ void operator()(const f32x4 (&acc)[2][2][4][2], const Unit& u, int wr, int wc, int fr, int fq) const {
        const int rowt = u.pm * BM; const bool lat = rowt < TLAT;
        const int j = lat ? rowt / SEQ : 4;
        const float* gate = modL + j * 6144 + gate_chunk * 1024;
        const float* xin = lat ? xin_lat + (size_t)rowt * DM : xin_ctx + (size_t)(rowt - TLAT) * DM;
        float* xo = lat ? out_lat + (size_t)rowt * DM : out_ctx + (size_t)(rowt - TLAT) * DM;
        const int col0 = u.pn * BM + wc * 32 + 8 * fq;
        typedef unsigned u32x2 __attribute__((ext_vector_type(2)));
        bf16_t* x1p = rowt < X1_SPLIT ? x1a + (size_t)rowt * DM : x1b + (size_t)(rowt - X1_SPLIT) * DM;
        f32x4 gv[2][2];
#pragma unroll
        for (int bj = 0; bj < 2; ++bj)
#pragma unroll
            for (int n = 0; n < 2; ++n) gv[bj][n] = *(const f32x4*)(gate + col0 + bj * HALF + 4 * n);
        f32x4 xa[2][2][2], xb[2][2][2];
#define RES_LOAD(dst, p) do { _Pragma("unroll") for (int g_ = 0; g_ < 2; ++g_) { const int gi_ = (p) * 2 + g_, ai_ = gi_ >> 2, m_ = gi_ & 3; const size_t off_ = (size_t)(wr * 64 + fr + ai_ * HALF + m_ * 16) * DM + col0; \
            _Pragma("unroll") for (int bj = 0; bj < 2; ++bj) _Pragma("unroll") for (int n = 0; n < 2; ++n) { if (flags & 1) { const u32x2 w_ = *(const u32x2*)(x1p + off_ + bj * HALF + 4 * n); dst[g_][bj][n] = (f32x4){__builtin_bit_cast(float, w_.x << 16), __builtin_bit_cast(float, w_.x & 0xffff0000u), __builtin_bit_cast(float, w_.y << 16), __builtin_bit_cast(float, w_.y & 0xffff0000u)}; } \
              else dst[g_][bj][n] = *(const f32x4*)(xin + off_ + bj * HALF + 4 * n); } } } while (0)
#define RES_STORE(src, p) do { _Pragma("unroll") for (int g_ = 0; g_ < 2; ++g_) { const int gi_ = (p) * 2 + g_, ai_ = gi_ >> 2, m_ = gi_ & 3; const size_t off_ = (size_t)(wr * 64 + fr + ai_ * HALF + m_ * 16) * DM + col0; \
            _Pragma("unroll") for (int bj = 0; bj < 2; ++bj) _Pragma("unroll") for (int n = 0; n < 2; ++n) { const f32x4 r_ = src[g_][bj][n] + gv[bj][n] * acc[ai_][bj][m_][n]; \
              if (flags & 2) { u32x2 w_; w_.x = pk2(r_.x, r_.y); w_.y = pk2(r_.z, r_.w); *(u32x2*)(x1p + off_ + bj * HALF + 4 * n) = w_; } else *(f32x4*)(xo + off_ + bj * HALF + 4 * n) = r_; } } } while (0)
        RES_LOAD(xa, 0);
        RES_LOAD(xb, 1); RES_STORE(xa, 0);
        RES_LOAD(xa, 2); RES_STORE(xb, 1);
        RES_LOAD(xb, 3); RES_STORE(xa, 2);
        RES_STORE(xb, 3);
#undef RES_LOAD
#undef RES_STORE
    }
};
struct EpiFfUp {
    static constexpr bool PERM = true, AFTER_DRAIN = false;
    bf16_t* HID; const float* cw; float* GE; float* PE; float* UE;
    __device__ __forceinline__ void operator()(const f32x4 (&acc)[2][2][4][2], const Unit& u, int wr, int wc, int fr, int fq) const {
        const int ch0 = u.pn * HALF + wc * 32 + 8 * fq;
        f32x4 w0[2], w1[2], w2[2];
#pragma unroll
        for (int n = 0; n < 2; ++n) { w0[n] = *(const f32x4*)(cw + ch0 + 4 * n); w1[n] = *(const f32x4*)(cw + DFF + ch0 + 4 * n); w2[n] = *(const f32x4*)(cw + 2 * DFF + ch0 + 4 * n); }
#pragma unroll
        for (int ai = 0; ai < 2; ++ai) {
            const int blk = u.pm * 4 + ai * 2 + wr; const int rowb = u.pm * BM + ai * HALF + wr * 64;
#pragma unroll
            for (int m = 0; m < 4; ++m) {
                float hv[8], cv[8];
#pragma unroll
                for (int n = 0; n < 2; ++n)
#pragma unroll
                    for (int e = 0; e < 4; ++e) {
                        const float g = acc[ai][0][m][n][e];
                        const float gprev = (m > 0) ? acc[ai][0][m > 0 ? m - 1 : 0][n][e] : 0.f;
                        const float gnext = (m < 3) ? acc[ai][0][m < 3 ? m + 1 : 3][n][e] : 0.f;
                        const float up = __builtin_bit_cast(float, __builtin_amdgcn_update_dpp(0, __builtin_bit_cast(int, (fr == 15) ? gprev : g), 0x121, 0xF, 0xF, true));
                        const float dn = __builtin_bit_cast(float, __builtin_amdgcn_update_dpp(0, __builtin_bit_cast(int, (fr == 0) ? gnext : g), 0x12F, 0xF, 0xF, true));
                        const float conv = w0[n][e] * up + w1[n][e] * g + w2[n][e] * dn;
                        cv[4 * n + e] = conv;
                        hv[4 * n + e] = conv * __builtin_amdgcn_rcpf(1.f + __expf(-conv)) * acc[ai][1][m][n][e];
                    }
                u32x4 w; w.x = pk2(hv[0], hv[1]); w.y = pk2(hv[2], hv[3]); w.z = pk2(hv[4], hv[5]); w.w = pk2(hv[6], hv[7]);
                *(u32x4*)(HID + (size_t)(rowb + m * 16 + fr) * DFF + ch0) = w;
                if ((m == 0 && fr == 0) || (m == 3 && fr == 15)) {
                    const size_t eo = ((size_t)blk * 2 + (m == 0 ? 0 : 1)) * DFF + ch0;
#pragma unroll
                    for (int n = 0; n < 2; ++n) { *(f32x4*)(GE + eo + 4 * n) = acc[ai][0][m][n]; *(f32x4*)(UE + eo + 4 * n) = acc[ai][1][m][n];
                        *(f32x4*)(PE + eo + 4 * n) = (f32x4){cv[4 * n], cv[4 * n + 1], cv[4 * n + 2], cv[4 * n + 3]}; }
                }
            }
        }
    }
};
struct EpiPartial {
    static constexpr bool PERM = true, AFTER_DRAIN = false;
    float* P;
    __device__ __forceinline__ void operator()(const f32x4 (&acc)[2][2][4][2], const Unit& u, int wr, int wc, int fr, int fq) const {
        float* xo = P + ((size_t)u.ks * TCTX + (size_t)(u.pm * BM - TLAT)) * DM; const int col0 = u.pn * BM + wc * 32 + 8 * fq;
#pragma unroll
        for (int ai = 0; ai < 2; ++ai)
#pragma unroll
            for (int m = 0; m < 4; ++m) { const size_t off = (size_t)(wr * 64 + fr + ai * HALF + m * 16) * DM + col0;
#pragma unroll
                for (int bj = 0; bj < 2; ++bj)
#pragma unroll
                    for (int n = 0; n < 2; ++n) *(f32x4*)(xo + off + bj * HALF + 4 * n) = acc[ai][bj][m][n]; }
    }
};
struct EpiAll {
    static constexpr bool PERM = true, AFTER_DRAIN = false;
    int mode, ldc; const void* a0; const void* a1; const void* a2; const void* a3; const void* a4; const void* x1a; const void* x1b;
    __device__ __forceinline__ void operator()(const f32x4 (&acc)[2][2][4][2], const Unit& u, int wr, int wc, int fr_, int fq_) const {
        int ln = (int)__builtin_amdgcn_mbcnt_hi(~0u, __builtin_amdgcn_mbcnt_lo(~0u, 0u)); asm volatile("" : "+v"(ln));
        const int fr = ln & 15, fq = ln >> 4; (void)fr_; (void)fq_;
        if (mode == 0) { EpiStore E{(bf16_t*)a0, ldc}; E(acc, u, wr, wc, fr, fq); }
        else if (mode == 1) { EpiResid E{(const float*)a0, (const float*)a1, (float*)a2, (float*)a3, (const float*)a4, 0, (bf16_t*)x1a, (bf16_t*)x1b, ldc}; E(acc, u, wr, wc, fr, fq); }
        else if (mode == 2) { EpiFfUp E{(bf16_t*)a0, (const float*)a1, (float*)a2, (float*)a2 + EDGE_N, (float*)a2 + 2 * EDGE_N}; E(acc, u, wr, wc, fr, fq); }
        else if (mode == 3) { EpiPartial E{(float*)a3}; E(acc, u, wr, wc, fr, fq); }
        else if (mode == 4) { EpiKv E{(bf16_t*)a0, (const float*)a1, (__attribute__((address_space(3))) float*)(131072u)}; E(acc, u, wr, wc, fr, fq); }
        else { EpiIn E{(unsigned char*)a0, (const float*)a1, (const float*)a2, (const float*)a3, (__attribute__((address_space(3))) float*)(131072u)}; E(acc, u, wr, wc, fr, fq); }
    }
};
}

__device__ __forceinline__ void tr_item(const float* W, int N, int k0, int n0, bf16* WT, int Kd, int dst_row0, LAS float* scr, int lane, bool fold, const float* pw, const float* ps) {
#pragma unroll 8
    for (int i = 0; i < 32; ++i) { const int kk = 2 * i + (lane >> 5); scr[kk * 33 + (lane & 31)] = W[(size_t)(k0 + kk) * N + n0 + (lane & 31)]; }
    LDS_WAIT(); asm volatile("" ::: "memory");
    if (fold) {
        const int n = lane & 31, c0 = (lane >> 5) * 32; float res[32];
#pragma unroll
        for (int cc = 0; cc < 32; ++cc) res[cc] = 0.f;
        for (int d = 0; d < 64; ++d) { const float s = scr[d * 33 + n] * ps[d];
#pragma unroll
            for (int cc = 0; cc < 32; ++cc) res[cc] += pw[(c0 + cc) * 64 + d] * s; }
        LDS_WAIT(); asm volatile("" ::: "memory");
#pragma unroll
        for (int cc = 0; cc < 32; ++cc) scr[(c0 + cc) * 33 + n] = res[cc];
        LDS_WAIT(); asm volatile("" ::: "memory");
    }
    const int c = lane & 7;
#pragma unroll
    for (int j = 0; j < 4; ++j) { const int n = (lane >> 3) + 8 * j; const LAS float* s = scr + (8 * c) * 33 + n;
        v4u o; o.x = pk2(s[0 * 33], s[1 * 33]); o.y = pk2(s[2 * 33], s[3 * 33]); o.z = pk2(s[4 * 33], s[5 * 33]); o.w = pk2(s[6 * 33], s[7 * 33]);
        *(v4u*)(WT + (size_t)(dst_row0 + n) * Kd + k0 + 8 * c) = o; }
    LDS_WAIT(); asm volatile("" ::: "memory");
}

__device__ __forceinline__ void norm_mod_pass(const float* xlat, float* xctx, const float* gvec, const float* modL, int ch_sh, int ch_sc, bf16* H, int nrows, int gw, int NGW, int lane, const bf16* x1a, const bf16* x1b, const float* P, int nsplit, const float* pgate) {
    const int nrows_main = (nsplit > 0 && nrows > TLAT) ? TLAT : nrows;
    for (int chk = gw; chk < nrows_main / 16; chk += NGW) {
        const int r0 = chk * 16; const int j = r0 < TLAT ? r0 / SEQ : 4;
        const float* sc = modL + j * 6144 + ch_sc * 1024; const float* sh = modL + j * 6144 + ch_sh * 1024;
        f32x4 gm[4], sv[4];
#pragma unroll
        for (int jj = 0; jj < 4; ++jj) { const int c = 4 * lane + 256 * jj; gm[jj] = *(const f32x4*)(gvec + c) * (*(const f32x4*)(sc + c) + 1.0f); sv[jj] = *(const f32x4*)(sh + c); }
        f32x4 v[4], vn[4];
#define NROW_LOAD(dst, r_) do { if (x1a != nullptr && (r_) < TLAT) { const bf16* xb_ = (r_) < X1_SPLIT ? x1a + (size_t)(r_) * DM : x1b + (size_t)((r_) - X1_SPLIT) * DM; \
            _Pragma("unroll") for (int jj = 0; jj < 4; ++jj) { const v2u w_ = *(const v2u*)(xb_ + 4 * lane + 256 * jj); dst[jj] = (f32x4){bflo(w_.x), bfhi(w_.x), bflo(w_.y), bfhi(w_.y)}; } } \
          else { const float* xr_ = (r_) < TLAT ? xlat + (size_t)(r_) * DM : xctx + (size_t)((r_) - TLAT) * DM; _Pragma("unroll") for (int jj = 0; jj < 4; ++jj) dst[jj] = *(const f32x4*)(xr_ + 4 * lane + 256 * jj); } } while (0)
        NROW_LOAD(v, r0);
        for (int rr = 0; rr < 16; ++rr) { const int r = r0 + rr;
            if (rr + 1 < 16) { const int r1 = r + 1; NROW_LOAD(vn, r1); }
            float ss = 0.f;
#pragma unroll
            for (int jj = 0; jj < 4; ++jj) ss += (v[jj].x * v[jj].x + v[jj].y * v[jj].y) + (v[jj].z * v[jj].z + v[jj].w * v[jj].w);
            ss = wave_sum(ss); const float rs = 1.0f / sqrtf(ss * (1.0f / DM) + EPSN);
#pragma unroll
            for (int jj = 0; jj < 4; ++jj) { const f32x4 o = v[jj] * rs * gm[jj] + sv[jj]; v2u w; w.x = pk2(o.x, o.y); w.y = pk2(o.z, o.w);
                *(v2u*)(H + (size_t)r * DM + 4 * lane + 256 * jj) = w; }
#pragma unroll
            for (int jj = 0; jj < 4; ++jj) v[jj] = vn[jj];
        }
    }
    if (nrows_main < nrows) {
        const float* sc = modL + 4 * 6144 + ch_sc * 1024; const float* sh = modL + 4 * 6144 + ch_sh * 1024;
        for (int r = TLAT + gw; r < nrows; r += NGW) {
            f32x4 v[4], pp_[4][11];
#pragma unroll
            for (int jj = 0; jj < 4; ++jj) { const int cidx = 4 * lane + 256 * jj; v[jj] = *(const f32x4*)(xctx + (size_t)(r - TLAT) * DM + cidx);
#pragma unroll
                for (int s = 0; s < 11; ++s) { const int se = s < nsplit ? s : nsplit - 1; pp_[jj][s] = *(const f32x4*)(P + ((size_t)se * TCTX + (r - TLAT)) * DM + cidx); } }
            float ss = 0.f;
#pragma unroll
            for (int jj = 0; jj < 4; ++jj) { const int cidx = 4 * lane + 256 * jj; f32x4 a = (f32x4){0.f, 0.f, 0.f, 0.f};
#pragma unroll
                for (int s = 0; s < 11; ++s) a += pp_[jj][s] * (s < nsplit ? 1.f : 0.f);
                v[jj] += *(const f32x4*)(pgate + cidx) * a; *(f32x4*)(xctx + (size_t)(r - TLAT) * DM + cidx) = v[jj];
                ss += (v[jj].x * v[jj].x + v[jj].y * v[jj].y) + (v[jj].z * v[jj].z + v[jj].w * v[jj].w); }
            ss = wave_sum(ss); const float rs = 1.0f / sqrtf(ss * (1.0f / DM) + EPSN);
#pragma unroll
            for (int jj = 0; jj < 4; ++jj) { const int cidx = 4 * lane + 256 * jj; const f32x4 gmv = *(const f32x4*)(gvec + cidx) * (*(const f32x4*)(sc + cidx) + 1.0f);
                const f32x4 o = v[jj] * rs * gmv + *(const f32x4*)(sh + cidx); v2u w; w.x = pk2(o.x, o.y); w.y = pk2(o.z, o.w);
                *(v2u*)(H + (size_t)r * DM + cidx) = w; }
        }
    }
}

__device__ __forceinline__ float rope_lane(float v, int n, int lane, const float* rope) {
    const int axis = lane >> 5, half = (lane >> 4) & 1, f = lane & 15; const int pos = axis ? (n & 63) : (n >> 6);
    const float c = rope[(pos * 16 + f) * 2], s = rope[(pos * 16 + f) * 2 + 1];
    const float partner = __shfl_xor(v, 16);
    return half ? v * c + partner * s : v * c - partner * s;
}

__device__ __forceinline__ void prep_tokens(const bf16* Y, bf16* MIX, const float* scw, int tb, int te, int wi, int ws_, int lane) {
    int inp_ = INP; asm volatile("" : "+s"(inp_));
    const int ch = 4 * lane, grp = lane >> 4, hw = 1 << grp;
    const f32x4 cw0 = *(const f32x4*)(scw + ch), cw1 = *(const f32x4*)(scw + 256 + ch), cw2 = *(const f32x4*)(scw + 512 + ch);
    for (int t0 = tb + wi * 4; t0 < te; t0 += ws_ * 4)
    for (int ti = 0; ti < 4; ++ti) { const int t = t0 + ti;
        const bf16* y = Y + (size_t)t * INP; const bool lat = t < TLAT; const int n = lat ? (t & (SEQ - 1)) : ((t - TLAT) & (CTXL - 1)); const int len = lat ? SEQ : CTXL;
        const bool hp = n > 0, hn = n < len - 1; const long op = hp ? -(long)inp_ : 0, on = hn ? (long)inp_ : 0; const float fp = hp ? 1.f : 0.f, fn = hn ? 1.f : 0.f;
        const v2u gb = *(const v2u*)(y + 704 + ch), c1 = *(const v2u*)(y + 960 + ch), i1 = *(const v2u*)(y + 1216 + ch);
        const v2u c0 = *(const v2u*)(y + op + 960 + ch), i0 = *(const v2u*)(y + op + 1216 + ch), c2 = *(const v2u*)(y + on + 960 + ch), i2 = *(const v2u*)(y + on + 1216 + ch);
        v2u pv[16]; float pw[16];
#pragma unroll
        for (int d = -8; d < 8; ++d) { const int s = n + d; const bool ok = d >= -hw && d < hw && s >= 0 && s < len; pw[d + 8] = ok ? 1.f : 0.f;
            pv[d + 8] = *(const v2u*)(y + (ok ? (long)d * inp_ : 0) + 448 + ch); }
        { const f32x4 w0 = cw0 * fp, w2 = cw2 * fn;
          const float o0 = bflo(gb.x) * (w0.x * bflo(c0.x) * bflo(i0.x) + cw1.x * bflo(c1.x) * bflo(i1.x) + w2.x * bflo(c2.x) * bflo(i2.x));
          const float o1 = bfhi(gb.x) * (w0.y * bfhi(c0.x) * bfhi(i0.x) + cw1.y * bfhi(c1.x) * bfhi(i1.x) + w2.y * bfhi(c2.x) * bfhi(i2.x));
          const float o2 = bflo(gb.y) * (w0.z * bflo(c0.y) * bflo(i0.y) + cw1.z * bflo(c1.y) * bflo(i1.y) + w2.z * bflo(c2.y) * bflo(i2.y));
          const float o3 = bfhi(gb.y) * (w0.w * bfhi(c0.y) * bfhi(i0.y) + cw1.w * bfhi(c1.y) * bfhi(i1.y) + w2.w * bfhi(c2.y) * bfhi(i2.y));
          v2u w; w.x = pk2(o0, o1); w.y = pk2(o2, o3); *(v2u*)(MIX + (size_t)t * DM + 768 + ch) = w; }
        { float s0 = 0.f, s1 = 0.f, s2 = 0.f, s3 = 0.f;
#pragma unroll
          for (int j = 0; j < 16; ++j) { s0 += pw[j] * bflo(pv[j].x); s1 += pw[j] * bfhi(pv[j].x); s2 += pw[j] * bflo(pv[j].y); s3 += pw[j] * bfhi(pv[j].y); }
          const int lo = (n - hw) > 0 ? (n - hw) : 0, hi = (n + hw) < len ? (n + hw) : len; const float icnt = 1.0f / (float)(hi - lo);
          const v2u pc = pv[8];
          v2u w; w.x = pk2(s0 * icnt - bflo(pc.x), s1 * icnt - bfhi(pc.x)); w.y = pk2(s2 * icnt - bflo(pc.y), s3 * icnt - bfhi(pc.y)); *(v2u*)(MIX + (size_t)t * DM + 512 + ch) = w; }
    }
}

__global__ void __launch_bounds__(512) mega(Params p) {
    extern __shared__ __attribute__((aligned(16))) unsigned char lds[];
    cg::grid_group grid = cg::this_grid();
    CParams* pp = (CParams*)__builtin_amdgcn_kernarg_segment_ptr();
    const int ph_lo = pp->ph_lo, ph_hi = pp->ph_hi;
    { const int t0 = tidx(); volatile LAS unsigned* bar_st0 = (volatile LAS unsigned*)((LAS unsigned char*)lds + LDS_ST_OFF); unsigned* barw0 = (unsigned*)(pp->ws + WS_BAR);
      if (t0 < 2) bar_st0[t0] = 0u;
      if (blockIdx.x == 0) for (int i = t0; i < XCD_BAR_WORDS; i += 512) barw0[i] = 0u;
      __syncthreads(); }
    for (int ph = ph_lo; ph < ph_hi; ++ph) {
        asm volatile("" : "+s"(pp));
#define p (*pp)
        const int G = gridDim.x, bx = blockIdx.x;
        const int vcu = (G % 8 == 0) ? (bx % 8) * (G / 8) + bx / 8 : bx;
#define DEF_TID const int tid = tidx(), lane = tid & 63, wave = __builtin_amdgcn_readfirstlane(tid >> 6); const int gw = bx * 8 + wave, NGW = G * 8; (void)tid; (void)lane; (void)gw; (void)NGW;
        unsigned char* ws = p.ws;
        float* mod = (float*)(ws + WS_MOD); float* rope = (float*)(ws + WS_ROPE); float* XC = (float*)(ws + WS_XC);
        bf16* Wb = (bf16*)(ws + WS_W); bf16* H = (bf16*)(ws + WS_H); bf16* Y = (bf16*)(ws + WS_Y); bf16* QL = (bf16*)(ws + WS_QL); bf16* KVL = (bf16*)(ws + WS_KVL);
        bf16* Q = (bf16*)(ws + WS_Q); bf16* KV = (bf16*)(ws + WS_KV); bf16* KR = (bf16*)(ws + WS_KR); bf16* MIX = (bf16*)(ws + WS_MIX); bf16* HID = (bf16*)(ws + WS_HID);
        float* GE = (float*)(ws + WS_EDGE); float* PE = GE + EDGE_N; float* UE = PE + EDGE_N;
        float* out = p.out; float* PART_WO = (float*)(ws + WS_PART_WO); float* PART_DN = (float*)(ws + WS_PART_DN); bf16* X1A = (bf16*)(ws + WS_X1A); bf16* X1B = (bf16*)(ws + WS_X1B);

        if (ph == 0) { { DEF_TID
            LAS float* sv = (LAS float*)lds; LAS float* red = (LAS float*)(lds + 20480);
            for (int i = tid; i < 5 * 1024; i += 512) { const float v = i < 4096 ? p.in[1][i] : p.in[3][i - 4096]; sv[i] = v / (1.f + __expf(-v)); }
            __syncthreads();
            for (int it = bx; it < DEPTH * 96; it += G) {
                const int i = it / 96, nb = it % 96; const float* Wp = p.in[4] + (size_t)i * 1024 * 6144 + nb * 64 + lane;
                float a0 = 0.f, a1 = 0.f, a2 = 0.f, a3 = 0.f, a4 = 0.f;
#pragma unroll 8
                for (int kk = 0; kk < 128; ++kk) { const int k = wave * 128 + kk; const float w = Wp[(size_t)k * 6144];
                    a0 += sv[k] * w; a1 += sv[1024 + k] * w; a2 += sv[2048 + k] * w; a3 += sv[3072 + k] * w; a4 += sv[4096 + k] * w; }
                red[(wave * 5 + 0) * 64 + lane] = a0; red[(wave * 5 + 1) * 64 + lane] = a1; red[(wave * 5 + 2) * 64 + lane] = a2; red[(wave * 5 + 3) * 64 + lane] = a3; red[(wave * 5 + 4) * 64 + lane] = a4;
                __syncthreads();
                if (tid < 320) { const int j = tid >> 6, l = tid & 63; float s = 0.f;
#pragma unroll
                    for (int w = 0; w < 8; ++w) s += red[(w * 5 + j) * 64 + l];
                    mod[((size_t)i * 5 + j) * 6144 + nb * 64 + l] = s + p.in[5][(size_t)i * 6144 + nb * 64 + l]; }
                __syncthreads();
            }
            { const int gt = bx * 512 + tid;
              if (gt < 2048) { const int pos = gt >> 4, f = gt & 15; const float inv = exp2f(-(float)f * (13.287712379549449f / 16.f)); const float ang = (float)pos * inv;
                  const float rev = ang * 0.15915494309189535f; const float fr = rev - rintf(rev);
                  rope[gt * 2] = __builtin_amdgcn_cosf(fr); rope[gt * 2 + 1] = __builtin_amdgcn_sinf(fr); }
              for (int i = gt; i < TCTX * DM / 4; i += G * 512) ((f32x4*)XC)[i] = ((const f32x4*)p.in[2])[i];
              unsigned zz = 0u; asm volatile("" : "+v"(zz));
              for (int i = gt; i < DEPTH * 8192; i += G * 512) { const int l = i >> 13, r = i & 8191;
                  *(v4u*)(Wb + (size_t)l * W_LAYER + WO_IN + (size_t)INW * DM + (size_t)r * 8) = (v4u){zz, zz, zz, zz}; } }
            LAS float* scr = (LAS float*)(lds + 32768 + wave * 8448);
            for (int it = gw; it < DEPTH * 5632; it += NGW) {
                const int l = it / 5632; int r = it % 5632; bf16* WL = Wb + (size_t)l * W_LAYER;
                if (r < 736) { const int kb = r / 46, nb = r % 46; tr_item(p.in[8] + (size_t)l * DM * INW, INW, kb * 64, nb * 32, WL + WO_IN, DM, nb * 32, scr, lane, false, nullptr, nullptr); continue; } r -= 736;
                if (r < 96) { const int kb = r / 24, nb = r % 24; tr_item(p.in[11] + (size_t)l * QRK * 768, 768, kb * 64, nb * 32, WL + WO_Q, QRK, nb * 32, scr, lane, false, nullptr, nullptr); continue; } r -= 96;
                if (r < 64) { const int kb = r / 32, nb = r % 32; tr_item(p.in[12] + (size_t)l * KVRK * 1024, 1024, kb * 64, nb * 32, WL + WO_KV, KVRK, nb * 32, scr, lane, false, nullptr, nullptr); continue; } r -= 64;
                if (r < 512) { const int kb = r / 32, nb = r % 32; const bool fold = (kb >= 8 && kb < 12); const int g = kb - 8;
                    tr_item(p.in[20] + (size_t)l * DM * DM, DM, kb * 64, nb * 32, WL + WO_O, DM, nb * 32, scr, lane, fold, p.in[17] + (size_t)l * 16384 + (fold ? g * 4096 : 0), p.in[18] + (size_t)l * 256 + (fold ? g * 64 : 0)); continue; } r -= 512;
                if (r < 2816) { const int kb = r / 176, nb = r % 176; const int n0 = nb * 32, half = n0 >= DFF ? 1 : 0, ch = n0 - half * DFF; const int drow = 256 * (ch >> 7) + 128 * half + (ch & 127);
                    tr_item(p.in[21] + (size_t)l * DM * 2 * DFF, 2 * DFF, kb * 64, n0, WL + WO_UP, DM, drow, scr, lane, false, nullptr, nullptr); continue; } r -= 2816;
                { const int kb = r / 32, nb = r % 32; tr_item(p.in[23] + (size_t)l * DFF * DM, DM, kb * 64, nb * 32, WL + WO_DN, DFF, nb * 32, scr, lane, false, nullptr, nullptr); }
            }
        } } else {
            const int L = (ph - 1) / 10, k10 = (ph - 1) % 10, k = k10 < 4 ? k10 : k10 + 1;
            const bf16* WL = Wb + (size_t)L * W_LAYER;
            const float* modL = mod + (size_t)L * 5 * 6144;
            const float* xlat = (L == 0) ? p.in[0] : out; const float* xctx = XC;
            const int Mact = (L == DEPTH - 1) ? TLAT : TT;
            if (k == 0) { DEF_TID
                norm_mod_pass(xlat, XC, p.in[6] + L * DM, modL, 0, 1, H, TT, gw, NGW, lane, nullptr, nullptr, PART_DN, (L > 0) ? DFF / 256 : 0, modL - 5 * 6144 + 4 * 6144 + 5 * 1024);
            } else if (k == 2 && bx >= NCTXU) { DEF_TID
                prep_tokens(Y, MIX, p.in[19] + L * 3 * 256, 0, TLAT, (bx - NCTXU) * 8 + wave, (G - NCTXU) * 8, lane);
            } else if (k == 4) { DEF_TID
                const float* kn_g = p.in[15] + L * 128; const int hh = lane >> 4, dd = (lane & 15) * 8;
                const f32x4 kga = *(const f32x4*)(kn_g + dd), kgb = *(const f32x4*)(kn_g + dd + 4);
                for (int t0 = gw * 4; t0 < TT; t0 += NGW * 4) {
                    v4u rk[4];
#pragma unroll
                    for (int ti = 0; ti < 4; ++ti) rk[ti] = *(const v4u*)(KV + (size_t)(t0 + ti) * 1024 + hh * 256 + dd);
#pragma unroll
                    for (int ti = 0; ti < 4; ++ti) {
                        const float f0 = bflo(rk[ti].x), f1 = bfhi(rk[ti].x), f2 = bflo(rk[ti].y), f3 = bfhi(rk[ti].y), f4 = bflo(rk[ti].z), f5 = bfhi(rk[ti].z), f6 = bflo(rk[ti].w), f7 = bfhi(rk[ti].w);
                        float ss = ((f0 * f0 + f1 * f1) + (f2 * f2 + f3 * f3)) + ((f4 * f4 + f5 * f5) + (f6 * f6 + f7 * f7));
                        ss += __builtin_bit_cast(float, __builtin_amdgcn_update_dpp(0, __builtin_bit_cast(int, ss), 0xB1, 0xF, 0xF, true));
                        ss += __builtin_bit_cast(float, __builtin_amdgcn_update_dpp(0, __builtin_bit_cast(int, ss), 0x4E, 0xF, 0xF, true));
                        ss += __builtin_bit_cast(float, __builtin_amdgcn_update_dpp(0, __builtin_bit_cast(int, ss), 0x141, 0xF, 0xF, true));
                        ss += __builtin_bit_cast(float, __builtin_amdgcn_update_dpp(0, __builtin_bit_cast(int, ss), 0x140, 0xF, 0xF, true));
                        const float rs = 1.0f / sqrtf(ss * (1.0f / 128) + EPSN);
                        v4u w; w.x = pk2(f0 * rs * kga.x, f1 * rs * kga.y); w.y = pk2(f2 * rs * kga.z, f3 * rs * kga.w); w.z = pk2(f4 * rs * kgb.x, f5 * rs * kgb.y); w.w = pk2(f6 * rs * kgb.z, f7 * rs * kgb.w);
                        *(v4u*)(KV + (size_t)(t0 + ti) * 1024 + hh * 256 + dd) = w; }
                }
            } else if (k == 5) {
                const int NU = 512 + (L < DEPTH - 1 ? 16 : 0);
                for (int u = vcu; u < NU; u += G) {
                    int b, h, row0, lat0, nlat, ctx0, seq;
                    if (u < 512) { const int bh = u >> 5, qb = u & 31; b = bh >> 2; h = bh & 3; row0 = b * SEQ + qb * 256; lat0 = b * SEQ; nlat = SEQ; ctx0 = TLAT + b * CTXL; seq = SEQ + CTXL; }
                    else { const int j = u - 512; b = j >> 2; h = j & 3; row0 = TLAT + b * CTXL; lat0 = 0; nlat = 0; ctx0 = TLAT + b * CTXL; seq = CTXL; }
                    att::attn_unit(Q + (size_t)row0 * 768 + h * DQK, KV + h * 256, KR, MIX + (size_t)row0 * DM + h * 128, lat0, nlat, ctx0, seq, (char*)lds,
                                   p.in[13] + L * 128, p.in[14] + L * 64, rope, u < 512 ? (u & 31) * 256 : -1);
                    __syncthreads();
                }
            } else if (k == 7) { DEF_TID
                norm_mod_pass(out, XC, p.in[7] + L * DM, modL, 3, 4, H, Mact, gw, NGW, lane, X1A, X1B, PART_WO, (L < DEPTH - 1) ? DM / 128 : 0, modL + 4 * 6144 + 2 * 1024);
            } else if (k == 9) { DEF_TID
                const float* cw = p.in[22] + (size_t)L * 3 * DFF; const int nblk = Mact / 64;
                for (int i = bx * 512 + tid; i < nblk * 2 * (DFF / 4); i += G * 512) {
                    const int c = (i % (DFF / 4)) * 4, be = i / (DFF / 4), blk = be >> 1, e = be & 1; const int r = blk * 64 + (e ? 63 : 0);
                    f32x4 conv = *(const f32x4*)(PE + (size_t)be * DFF + c);
                    if (e == 0) { const bool start = r < TLAT ? ((r & (SEQ - 1)) == 0) : (((r - TLAT) & (CTXL - 1)) == 0);
                        if (!start) conv += *(const f32x4*)(cw + c) * *(const f32x4*)(GE + ((size_t)(blk - 1) * 2 + 1) * DFF + c); }
                    else { const int r1 = r + 1; const bool end = r1 < TLAT ? ((r1 & (SEQ - 1)) == 0) : (((r1 - TLAT) & (CTXL - 1)) == 0);
                        if (!end) conv += *(const f32x4*)(cw + 2 * DFF + c) * *(const f32x4*)(GE + ((size_t)(blk + 1) * 2) * DFF + c); }
                    const f32x4 uu = *(const f32x4*)(UE + (size_t)be * DFF + c);
                    v2u w; w.x = pk2(conv.x * __builtin_amdgcn_rcpf(1.f + __expf(-conv.x)) * uu.x, conv.y * __builtin_amdgcn_rcpf(1.f + __expf(-conv.y)) * uu.y);
                    w.y = pk2(conv.z * __builtin_amdgcn_rcpf(1.f + __expf(-conv.z)) * uu.z, conv.w * __builtin_amdgcn_rcpf(1.f + __expf(-conv.w)) * uu.w);
                    *(v2u*)(HID + (size_t)r * DFF + c) = w;
                }
            } else {
                const bool split_ctx = (k == 6 || k == 10) && L < DEPTH - 1;
                const int ng = (k == 3 || split_ctx) ? 2 : 1;
                for (int gi = 0; gi < ng; ++gi) {
                    pg8::Gemm g; pg8::EpiAll E; E.a1 = nullptr; E.a2 = nullptr; E.a3 = nullptr; E.a4 = nullptr; E.ldc = 0; E.x1a = X1A; E.x1b = X1B; int nsplit = 1, pm0 = 0;
                    if (k == 1 || k == 2) { g = pg8::Gemm{H, WL + WO_IN, k == 1 ? TLAT : TCTX, INP, DM, DM}; if (k == 2) pm0 = TLAT / 256; E.mode = 5; E.a0 = ws; E.a1 = p.in[9] + L * QRK; E.a2 = p.in[10] + L * KVRK; E.a3 = p.in[16] + L * 64; }
                    else if (k == 3 && gi == 0) { g = pg8::Gemm{QL, WL + WO_Q, TT, 768, QRK, QRK};   E.mode = 0; E.a0 = Q; E.ldc = 768; }
                    else if (k == 3) { g = pg8::Gemm{KVL, WL + WO_KV, TT, 1024, KVRK, KVRK}; E.mode = 4; E.a0 = KV; E.a1 = p.in[15] + L * 128; }
                    else if (k == 6 && gi == 0) { g = pg8::Gemm{MIX, WL + WO_O, TLAT, DM, DM, DM};    E.mode = 1; E.ldc = 2; E.a0 = xlat; E.a1 = XC; E.a2 = out; E.a3 = XC; E.a4 = modL + 2 * 1024; }
                    else if (k == 6) { g = pg8::Gemm{MIX, WL + WO_O, TCTX, DM, 128, DM}; nsplit = DM / 128; pm0 = TLAT / 256; E.mode = 3; E.a0 = nullptr; E.a3 = PART_WO; }
                    else if (k == 8) { g = pg8::Gemm{H, WL + WO_UP, Mact, 2 * DFF, DM, DM}; E.mode = 2; E.a0 = HID; E.a1 = p.in[22] + (size_t)L * 3 * DFF; E.a2 = GE; }
                    else if (gi == 0) { g = pg8::Gemm{HID, WL + WO_DN, TLAT, DM, DFF, DFF};  E.mode = 1; E.ldc = 1; E.a0 = out; E.a1 = XC; E.a2 = out; E.a3 = XC; E.a4 = modL + 5 * 1024; }
                    else             { g = pg8::Gemm{HID, WL + WO_DN, TCTX, DM, 256, DFF}; nsplit = DFF / 256; pm0 = TLAT / 256; E.mode = 3; E.a0 = nullptr; E.a3 = PART_DN; }
                    pg8::StaticOrder S; S.init(g.M, g.N, G, bx); S.nsplit = nsplit; S.pm0 = pm0;
                    pg8::gemm_phase<pg8::EpiAll, pg8::StaticOrder, true, true>((LAS unsigned char*)lds, g, S, E);
                }
                if (k == 3) { DEF_TID prep_tokens(Y, MIX, p.in[19] + L * 3 * 256, TLAT, TT, gw, NGW, lane); }
            }
        }
        if (ph + 1 < ph_hi) {
            volatile LAS unsigned* bar_st = (volatile LAS unsigned*)((LAS unsigned char*)lds + LDS_ST_OFF); unsigned* barw = (unsigned*)(pp->ws + WS_BAR);
            if (ph == ph_lo) { grid.sync(); (void)xcd_barrier_post(barw, bar_st); }
            else { XcdBarrier xb; xb.bar = barw; xb.x = xb_xcc_id(); xb.st = bar_st; xcd_barrier(xb); } }
#undef p
    }
}

extern "C" void kernel_launch(void* const* d_in, const int* in_sizes, int n_in, void* d_out, int out_size, void* d_ws, size_t ws_size, hipStream_t stream) {
    static int grid = 0;
    if (grid == 0) {
        if (n_in != 24 || in_sizes[0] != TLAT * DM || out_size != TLAT * DM || ws_size < WS_END) { fprintf(stderr, "kernel_launch: unexpected shapes (n_in %d, ws %zu)\n", n_in, ws_size); grid = -1; return; }
        int dev = 0, cus = 0, per_cu = 0;
        hipGetDevice(&dev); hipDeviceGetAttribute(&cus, hipDeviceAttributeMultiprocessorCount, dev);
        if (hipFuncSetAttribute((const void*)mega, hipFuncAttributeMaxDynamicSharedMemorySize, LDS_BYTES) != hipSuccess) { fprintf(stderr, "kernel_launch: hipFuncSetAttribute failed\n"); grid = -1; return; }
        if (hipOccupancyMaxActiveBlocksPerMultiprocessor(&per_cu, (const void*)mega, 512, LDS_BYTES) != hipSuccess || per_cu < 1) { fprintf(stderr, "kernel_launch: occupancy query says %d\n", per_cu); per_cu = 1; }
        (void)hipGetLastError();
        grid = cus;
    }
    if (grid < 0) return;
    Params p{};
    for (int i = 0; i < 24; ++i) p.in[i] = (const float*)d_in[i];
    p.out = (float*)d_out; p.ws = (unsigned char*)d_ws;
    p.ph_lo = 0; p.ph_hi = NPH;
    void* args[] = {&p};
    hipError_t e = hipLaunchCooperativeKernel((const void*)mega, dim3(grid), dim3(512), args, LDS_BYTES, stream);
    if (e != hipSuccess) fprintf(stderr, "cooperative launch failed: %s (grid %d)\n", hipGetErrorString(e), grid);
}
```

```cpp
#include <hip/hip_runtime.h>
#include <hip/hip_cooperative_groups.h>
#include <cstdio>
#include <cstdint>
namespace cg = cooperative_groups;

constexpr int DM = 1024, NB = 4, SEQ = 8192, DEPTH = 4, CTXL = 256;
constexpr int TLAT = NB * SEQ, TCTX = NB * CTXL, TT = TLAT + TCTX;
constexpr int INW = 1472, INP = 1536, QRK = 256, KVRK = 128, NHEAD = 4, DQK = 192, DFF = 2816;
constexpr float EPSN = 1e-6f;
__device__ __forceinline__ int tidx() { int t = (int)__builtin_amdgcn_workitem_id_x(); asm volatile("" : "+v"(t)); return t; }
namespace pg8 {
#define PG8_LAS __attribute__((address_space(3)))
typedef unsigned short bf16_t;
typedef short bf16x8 __attribute__((ext_vector_type(8)));
typedef float f32x4 __attribute__((ext_vector_type(4)));
typedef unsigned u32x4 __attribute__((ext_vector_type(4)));
constexpr int BM = 256, BK = 64, HALF = 128, HTB = HALF * BK * 2  , STAGE_BYTES = 8 * HTB, NXCD = 8, WGM = 8;

__host__ __device__ __forceinline__ int lds_byte(int r, int c) { const int st = (r >> 4) * 2 + (c >> 5), rr = r & 15, cc = c & 31, ob = rr * 64 + cc * 2; return st * 1024 + (ob ^ (((ob >> 9) & 1) << 5)); }
__host__ __device__ __forceinline__ void stage_rc(int b, int& R, int& C) { const int st = b / 1024, sb = b % 1024, swz = sb ^ (((sb >> 9) & 1) << 5); R = (st >> 1) * 16 + swz / 64; C = (st & 1) * 32 + (swz % 64) / 2; }
__host__ __device__ __forceinline__ int perm32(int rho) { const int n = rho >> 4, i = rho & 15; return 8 * (i >> 2) + 4 * n + (i & 3); }

struct Unit { int pm, pn, ks; };
struct Gemm { const bf16_t* A; const bf16_t* Bt; int M, N, K, ld; };

struct StaticOrder {
    int nM, nN, nwg, G, c;
    __host__ __device__ void init(int M, int N, int G_, int c_) { nM = M / BM; nN = N / BM; nwg = nM * nN; G = G_; c = c_; }
    int nsplit = 1, pm0 = 0;
    __host__ __device__ bool next(int i, Unit& u) const {
        if (nsplit > 1 || pm0 > 0) { const long Ls = (long)i * G + c; if (Ls >= (long)nwg * nsplit) return false; const int t = (int)(Ls / nsplit); u.ks = (int)(Ls % nsplit); u.pn = t % nN; u.pm = pm0 + t / nN; return true; }
        const long L = (long)i * G + c; if (L >= nwg) return false;
        int wgid = (int)L; { const int q = nwg / NXCD, r = nwg % NXCD, xcd = wgid % NXCD, off = wgid / NXCD; wgid = (xcd < r ? xcd * (q + 1) : r * (q + 1) + (xcd - r) * q) + off; }
        const int nig = WGM * nN, gid = wgid / nig, fm = gid * WGM, gsz = (nM - fm) < WGM ? (nM - fm) : WGM;
        u.pm = fm + ((wgid % nig) % gsz); u.pn = (wgid % nig) / gsz; u.ks = 0; return true;
    }
    __device__ __forceinline__ void a_ready(const Unit&) const {}
    __device__ __forceinline__ void done(const Unit&) const {}
};

__device__ __forceinline__ unsigned cvt_pk_bf16(float lo, float hi) { unsigned r; asm volatile("v_cvt_pk_bf16_f32 %0, %1, %2" : "=v"(r) : "v"(lo), "v"(hi)); return r; }
template <class Epi, class Sched, bool ALIGN_EPI = false, bool SP2 = false>
__device__ __forceinline__ void gemm_phase(PG8_LAS unsigned char* lds, const Gemm g, const Sched& S, const Epi& E) {
    const int tid = tidx(), wid = __builtin_amdgcn_readfirstlane(tid >> 6), lane = tid & 63, wr = wid >> 2, wc = wid & 3, fr = lane & 15, fq = lane >> 4;
    const int K = g.K, nt = K / BK;
    unsigned voffA[2], voffB[2];
#pragma unroll
    for (int i = 0; i < 2; ++i) { int R, C; stage_rc(tid * 16 + i * 8192, R, C); const int Rb = Epi::PERM ? ((R & ~31) + perm32(R & 31)) : R;
        voffA[i] = (unsigned)(R * g.ld + C) * 2u; voffB[i] = (unsigned)(Rb * g.ld + C) * 2u; }
    const size_t kstep = (size_t)(BK * 2);
    const size_t hstep = (size_t)HALF * g.ld * 2, kslice = (size_t)K * 2;
    const size_t tstep = 2 * hstep;
    const unsigned ldsw = (unsigned)wid * 1024u;
    const int aoff = lds_byte(wr * 64 + fr, fq * 8), boff = lds_byte(wc * 32 + fr, fq * 8);
#define PG8_SA(b, h) (((b) * 2 + (h)) * HTB)
#define PG8_SB(b, h) ((4 + (b) * 2 + (h)) * HTB)
#define PG8_STAGE(bufoff, gbase, voff) do { _Pragma("unroll") for (int _i = 0; _i < 2; ++_i) \
        __builtin_amdgcn_global_load_lds((const unsigned*)((const char*)(gbase) + (voff)[_i]), (PG8_LAS unsigned*)(lds + (bufoff) + ldsw + _i * 8192), 16, 0, 0); } while (0)
#define PG8_LDA(dst, b, h) do { _Pragma("unroll") for (int m = 0; m < 4; ++m) _Pragma("unroll") for (int k = 0; k < 2; ++k) dst[m][k] = *(const PG8_LAS bf16x8*)(lds + PG8_SA(b, h) + aoff + m * 2048 + k * 1024); } while (0)
#define PG8_LDB(dst, b, h) do { _Pragma("unroll") for (int n = 0; n < 2; ++n) _Pragma("unroll") for (int k = 0; k < 2; ++k) dst[n][k] = *(const PG8_LAS bf16x8*)(lds + PG8_SB(b, h) + boff + n * 2048 + k * 1024); } while (0)
#define PG8_MMA(ai, bj, At, Bt) do { __builtin_amdgcn_s_setprio(1); _Pragma("unroll") for (int m = 0; m < 4; ++m) _Pragma("unroll") for (int n = 0; n < 2; ++n) _Pragma("unroll") for (int k = 0; k < 2; ++k) \
        acc[ai][bj][m][n] = __builtin_amdgcn_mfma_f32_16x16x32_bf16(Bt[n][k], At[m][k], acc[ai][bj][m][n], 0, 0, 0); __builtin_amdgcn_s_setprio(0); } while (0)
#define PG8_WAIT_V(n) asm volatile("s_waitcnt vmcnt(" #n ")" ::: "memory")
#define PG8_WAIT_L(n) asm volatile("s_waitcnt lgkmcnt(" #n ")" ::: "memory")
#define PG8_BAR __builtin_amdgcn_s_barrier()
#define PG8_SCHED __builtin_amdgcn_sched_barrier(0)
    Unit cur, nxt; int ui = 0;
    if (!S.next(0, cur)) return;
    f32x4 acc[2][2][4][2];
#pragma unroll
    for (int a = 0; a < 2; ++a)
#pragma unroll
        for (int b = 0; b < 2; ++b)
#pragma unroll
            for (int m = 0; m < 4; ++m)
#pragma unroll
                for (int n = 0; n < 2; ++n) acc[a][b][m][n] = (f32x4){0.f, 0.f, 0.f, 0.f};
    bf16x8 At[4][2], B0[2][2], B1[2][2];
    const char* cA = (const char*)g.A + (size_t)cur.pm * tstep + cur.ks * kslice; const char* cB = (const char*)g.Bt + (size_t)cur.pn * tstep + cur.ks * kslice;
    S.a_ready(cur);
    if constexpr (SP2) {
        PG8_STAGE(PG8_SB(0, 0), cB, voffB); PG8_STAGE(PG8_SB(0, 1), cB + hstep, voffB); PG8_STAGE(PG8_SA(0, 0), cA, voffA); PG8_STAGE(PG8_SA(0, 1), cA + hstep, voffA);
        if (wr == 1) PG8_BAR;
        PG8_WAIT_V(2); PG8_BAR;
        PG8_STAGE(PG8_SB(1, 0), cB + kstep, voffB); PG8_STAGE(PG8_SA(1, 0), cA + kstep, voffA); PG8_STAGE(PG8_SB(1, 1), cB + hstep + kstep, voffB);
        PG8_WAIT_V(6); PG8_BAR;
    } else {
        PG8_STAGE(PG8_SB(0, 0), cB, voffB); PG8_STAGE(PG8_SA(0, 0), cA, voffA); PG8_STAGE(PG8_SB(0, 1), cB + hstep, voffB); PG8_STAGE(PG8_SA(0, 1), cA + hstep, voffA);
        if (wr == 1) PG8_BAR;
        PG8_WAIT_V(4); PG8_BAR;
        PG8_STAGE(PG8_SB(1, 0), cB + kstep, voffB); PG8_STAGE(PG8_SA(1, 0), cA + kstep, voffA); PG8_STAGE(PG8_SB(1, 1), cB + hstep + kstep, voffB);
        PG8_WAIT_V(6); PG8_BAR;
    }
    for (;;) {
        const bool has_next = S.next(ui + 1, nxt);
        const char* nA = has_next ? (const char*)g.A + (size_t)nxt.pm * tstep + nxt.ks * kslice : cA; const char* nB = has_next ? (const char*)g.Bt + (size_t)nxt.pn * tstep + nxt.ks * kslice : cB;
        for (int t = 0; t < nt; t += 2) {
            const bool last = (t == nt - 2);
            const char* a1 = cA + (size_t)(t + 1) * kstep;
            const char* a2 = last ? nA : cA + (size_t)(t + 2) * kstep; const char* b2 = last ? nB : cB + (size_t)(t + 2) * kstep;
            const char* a3 = a2 + kstep; const char* b3 = b2 + kstep;
            if (last && has_next) S.a_ready(nxt);
            if constexpr (SP2) {
            PG8_LDB(B0, 0, 0); PG8_LDB(B1, 0, 1); PG8_SCHED; PG8_LDA(At, 0, 0); PG8_STAGE(PG8_SA(1, 1), a1 + hstep, voffA);
            PG8_WAIT_V(8); PG8_WAIT_L(0); PG8_BAR; PG8_MMA(0, 0, At, B0); PG8_MMA(0, 1, At, B1); PG8_BAR; PG8_SCHED;
            PG8_LDA(At, 0, 1); PG8_STAGE(PG8_SB(0, 0), b2, voffB); PG8_STAGE(PG8_SB(0, 1), b2 + hstep, voffB); PG8_STAGE(PG8_SA(0, 0), a2, voffA);
            PG8_WAIT_V(8); PG8_WAIT_L(0); PG8_BAR; PG8_MMA(1, 0, At, B0); PG8_MMA(1, 1, At, B1); PG8_BAR; PG8_SCHED;
            PG8_LDB(B0, 1, 0); PG8_LDB(B1, 1, 1); PG8_SCHED; PG8_LDA(At, 1, 0); PG8_STAGE(PG8_SA(0, 1), a2 + hstep, voffA);
            PG8_WAIT_V(8); PG8_WAIT_L(0); PG8_BAR; PG8_MMA(0, 0, At, B0); PG8_MMA(0, 1, At, B1); PG8_BAR; PG8_SCHED;
            PG8_LDA(At, 1, 1); PG8_STAGE(PG8_SB(1, 0), b3, voffB); PG8_STAGE(PG8_SB(1, 1), b3 + hstep, voffB); PG8_STAGE(PG8_SA(1, 0), a3, voffA);
            PG8_WAIT_V(8); PG8_WAIT_L(0); PG8_BAR; PG8_MMA(1, 0, At, B0); PG8_MMA(1, 1, At, B1); PG8_BAR; PG8_SCHED;
            } else {
            PG8_LDB(B0, 0, 0); PG8_SCHED; PG8_LDA(At, 0, 0); PG8_STAGE(PG8_SA(1, 1), a1 + hstep, voffA);
            PG8_WAIT_L(8); PG8_BAR; PG8_WAIT_L(0); PG8_MMA(0, 0, At, B0); PG8_BAR; PG8_SCHED;
            PG8_LDB(B1, 0, 1); PG8_STAGE(PG8_SB(0, 0), b2, voffB);
            PG8_BAR; PG8_WAIT_L(0); PG8_MMA(0, 1, At, B1); PG8_BAR;
            PG8_LDA(At, 0, 1); PG8_STAGE(PG8_SA(0, 0), a2, voffA);
            PG8_BAR; PG8_WAIT_L(0); PG8_MMA(1, 0, At, B0); PG8_BAR; PG8_SCHED;
            PG8_STAGE(PG8_SB(0, 1), b2 + hstep, voffB);
            PG8_WAIT_V(6); PG8_BAR; PG8_MMA(1, 1, At, B1); PG8_BAR;
            PG8_LDB(B0, 1, 0); PG8_SCHED; PG8_LDA(At, 1, 0); PG8_STAGE(PG8_SA(0, 1), a2 + hstep, voffA);
            PG8_WAIT_L(8); PG8_BAR; PG8_WAIT_L(0); PG8_MMA(0, 0, At, B0); PG8_BAR; PG8_SCHED;
            PG8_LDB(B1, 1, 1); PG8_STAGE(PG8_SB(1, 0), b3, voffB);
            PG8_BAR; PG8_WAIT_L(0); PG8_MMA(0, 1, At, B1); PG8_BAR;
            PG8_LDA(At, 1, 1); PG8_STAGE(PG8_SA(1, 0), a3, voffA);
            PG8_BAR; PG8_WAIT_L(0); PG8_MMA(1, 0, At, B0); PG8_BAR; PG8_SCHED;
            PG8_STAGE(PG8_SB(1, 1), b3 + hstep, voffB);
            PG8_WAIT_V(6); PG8_BAR; PG8_MMA(1, 1, At, B1); PG8_BAR;
            }
        }
        if constexpr (ALIGN_EPI) { if (wr == 0) PG8_BAR; }
        if constexpr (!Epi::AFTER_DRAIN) { E(acc, cur, wr, wc, fr, fq); S.done(cur); }
        if (!has_next) break;
#pragma unroll
        for (int a = 0; a < 2; ++a)
#pragma unroll
            for (int b = 0; b < 2; ++b)
#pragma unroll
                for (int m = 0; m < 4; ++m)
#pragma unroll
                    for (int n = 0; n < 2; ++n) acc[a][b][m][n] = (f32x4){0.f, 0.f, 0.f, 0.f};
        cur = nxt; cA = nA; cB = nB; ++ui;
        if constexpr (ALIGN_EPI) { if (wr == 1) PG8_BAR; }
    }
    PG8_WAIT_V(0);
    if constexpr (!ALIGN_EPI) { if (wr == 0) PG8_BAR; }
    PG8_BAR;
    if constexpr (Epi::AFTER_DRAIN) { E.fused(acc, cur, wr, wc, fr, fq, lds, wid, lane); S.done(cur); }
#undef PG8_SA
#undef PG8_SB
#undef PG8_STAGE
#undef PG8_LDA
#undef PG8_LDB
#undef PG8_MMA
#undef PG8_WAIT_V
#undef PG8_WAIT_L
#undef PG8_BAR
#undef PG8_SCHED
}
}
namespace att {
typedef unsigned short bf16;
constexpr int NW = 8, QBLK = 32, KVBLK = 64;
constexpr float SCALE = 0.07216878364870323f;
constexpr float THR = 8.f;
constexpr int LDQ = 768, LDKN = 1024, LDKR = 64, LDV = 1024, LDO = 1024;
constexpr int SHM_V = KVBLK * 128 * 2, SHM_K = KVBLK * 192 * 2, QS_OFF = 3 * SHM_V + 3 * SHM_K + NW * 64 * 4, ATTN_LDS = QS_OFF + 512 * 4 * 16;
using bf16x8 = __attribute__((ext_vector_type(8))) short;
using s16x4  = __attribute__((ext_vector_type(4))) short;
using f32x16 = __attribute__((ext_vector_type(16))) float;
using f32x8  = __attribute__((ext_vector_type(8))) float;
using u32x4  = __attribute__((ext_vector_type(4))) unsigned;
#define KSWZ(row, colB) ((row) * 384 + ((colB) ^ ((((row) >> 1) & 7) << 4)))
#define SBAR() __builtin_amdgcn_sched_barrier(0)
__device__ __forceinline__ int crow(int r, int hi) { return (r & 3) + 8 * (r >> 2) + 4 * hi; }
__device__ __forceinline__ unsigned cvtpk(float lo, float hi) {
  unsigned r; asm volatile("v_cvt_pk_bf16_f32 %0, %1, %2" : "=v"(r) : "v"(lo), "v"(hi)); return r;
}
__device__ __forceinline__ void partialSM(f32x16& p0, f32x16& p1, float& m_reg, float& mn, float& alpha) {
  constexpr float C = SCALE * 1.4426950408889634f;
  float pmax = p0[0]; for (int r = 1; r < 16; ++r) pmax = fmaxf(pmax, p0[r]); for (int r = 0; r < 16; ++r) pmax = fmaxf(pmax, p1[r]);
  { auto rr = __builtin_amdgcn_permlane32_swap(__float_as_uint(pmax), __float_as_uint(pmax), false, false);
    pmax = fmaxf(__uint_as_float(rr[0]), __uint_as_float(rr[1])); }
  if (__builtin_expect(__all(pmax - m_reg <= THR / SCALE), 1)) { mn = m_reg; alpha = 1.f; }
  else { mn = fmaxf(m_reg, pmax); alpha = __builtin_amdgcn_exp2f((m_reg - mn) * C); m_reg = mn; }
  float mnC = -mn * C;
  for (int r = 0; r < 16; ++r) p0[r] = fmaf(p0[r], C, mnC); for (int r = 0; r < 16; ++r) p1[r] = fmaf(p1[r], C, mnC);
  for (int r = 0; r < 16; ++r) p0[r] = __builtin_amdgcn_exp2f(p0[r]);
}
__device__ __forceinline__ void finishSM(f32x16& p0, f32x16& p1, float alpha, float& l_reg, bf16x8& pa0, bf16x8& pa1, bf16x8& pa2, bf16x8& pa3) {
  for (int r = 0; r < 16; ++r) p1[r] = __builtin_amdgcn_exp2f(p1[r]);
  float ps = 0; for (int r = 0; r < 16; ++r) ps += p0[r]; for (int r = 0; r < 16; ++r) ps += p1[r];
  { auto rr = __builtin_amdgcn_permlane32_swap(__float_as_uint(ps), __float_as_uint(ps), false, false);
    ps = __uint_as_float(rr[0]) + __uint_as_float(rr[1]); }
  l_reg = l_reg * alpha + ps;
#define PK4(P, BASE, OUT) do { unsigned a0 = cvtpk(P[BASE + 0], P[BASE + 1]), a1 = cvtpk(P[BASE + 2], P[BASE + 3]);   \
    unsigned b0 = cvtpk(P[BASE + 4], P[BASE + 5]), b1 = cvtpk(P[BASE + 6], P[BASE + 7]);                              \
    auto r0 = __builtin_amdgcn_permlane32_swap(a0, b0, false, false); auto r1 = __builtin_amdgcn_permlane32_swap(a1, b1, false, false); \
    u32x4 w = {r0[0], r1[0], r0[1], r1[1]}; OUT = *reinterpret_cast<bf16x8*>(&w); } while (0)
  PK4(p0, 0, pa0); PK4(p0, 8, pa1); PK4(p1, 0, pa2); PK4(p1, 8, pa3);
#undef PK4
}
__device__ __forceinline__ int v_st(int k, int c) { const int kk = (k & ~0xC) | ((k & 4) << 1) | ((k & 8) >> 1); return ((kk >> 3) * 4 + (c >> 5)) * 512 + ((kk & 7) * 32 + (c & 31)) * 2; }
__device__ __forceinline__ int v_rd_base(int lane) { return ((lane & 3) << 3) | (((lane >> 2) & 3) << 6) | (((lane >> 4) & 1) << 5) | (((lane >> 5) & 1) << 8); }
constexpr int v_rd_off(int d0, int ks, int half) { return d0 * 512 + ks * 4096 + half * 2048; }
template <int OFF> __device__ __forceinline__ s16x4 tr_read(int vb) {
  s16x4 r; asm volatile("ds_read_b64_tr_b16 %0, %1 offset:%2" : "=&v"(r) : "v"(vb), "i"(OFF) : "memory"); return r;
}
template <int D0> __device__ __forceinline__ void pv_one(f32x16& od, int vb, bf16x8 pa0, bf16x8 pa1, bf16x8 pa2, bf16x8 pa3) {
  const s16x4 l0 = tr_read<v_rd_off(D0, 0, 0)>(vb), h0 = tr_read<v_rd_off(D0, 0, 1)>(vb), l1 = tr_read<v_rd_off(D0, 1, 0)>(vb), h1 = tr_read<v_rd_off(D0, 1, 1)>(vb);
  const s16x4 l2 = tr_read<v_rd_off(D0, 2, 0)>(vb), h2 = tr_read<v_rd_off(D0, 2, 1)>(vb), l3 = tr_read<v_rd_off(D0, 3, 0)>(vb), h3 = tr_read<v_rd_off(D0, 3, 1)>(vb);
  asm volatile("s_waitcnt lgkmcnt(0)" ::: "memory"); SBAR();
#define PK(L, H) (bf16x8){L[0], L[1], L[2], L[3], H[0], H[1], H[2], H[3]}
  od = __builtin_amdgcn_mfma_f32_32x32x16_bf16(pa0, PK(l0, h0), od, 0, 0, 0);
  od = __builtin_amdgcn_mfma_f32_32x32x16_bf16(pa1, PK(l1, h1), od, 0, 0, 0);
  od = __builtin_amdgcn_mfma_f32_32x32x16_bf16(pa2, PK(l2, h2), od, 0, 0, 0);
  od = __builtin_amdgcn_mfma_f32_32x32x16_bf16(pa3, PK(l3, h3), od, 0, 0, 0);
#undef PK
}
template <int D0> __device__ __forceinline__ void pv_rd(s16x4 (&f)[8], int vb) {
  f[0] = tr_read<v_rd_off(D0, 0, 0)>(vb); f[1] = tr_read<v_rd_off(D0, 0, 1)>(vb); f[2] = tr_read<v_rd_off(D0, 1, 0)>(vb); f[3] = tr_read<v_rd_off(D0, 1, 1)>(vb);
  f[4] = tr_read<v_rd_off(D0, 2, 0)>(vb); f[5] = tr_read<v_rd_off(D0, 2, 1)>(vb); f[6] = tr_read<v_rd_off(D0, 3, 0)>(vb); f[7] = tr_read<v_rd_off(D0, 3, 1)>(vb);
}
__device__ __forceinline__ void pv_mm(f32x16& od, const s16x4 (&f)[8], bf16x8 pa0, bf16x8 pa1, bf16x8 pa2, bf16x8 pa3) {
#define PK(L, H) (bf16x8){L[0], L[1], L[2], L[3], H[0], H[1], H[2], H[3]}
  od = __builtin_amdgcn_mfma_f32_32x32x16_bf16(pa0, PK(f[0], f[1]), od, 0, 0, 0);
  od = __builtin_amdgcn_mfma_f32_32x32x16_bf16(pa1, PK(f[2], f[3]), od, 0, 0, 0);
  od = __builtin_amdgcn_mfma_f32_32x32x16_bf16(pa2, PK(f[4], f[5]), od, 0, 0, 0);
  od = __builtin_amdgcn_mfma_f32_32x32x16_bf16(pa3, PK(f[6], f[7]), od, 0, 0, 0);
#undef PK
}
#define PV_WAIT(n, f) asm volatile("s_waitcnt lgkmcnt(" #n ")" : "+v"(f[0]), "+v"(f[1]), "+v"(f[2]), "+v"(f[3]), "+v"(f[4]), "+v"(f[5]), "+v"(f[6]), "+v"(f[7]) :: "memory")
__device__ __forceinline__ void pv_d0(f32x16* o, int vb, bf16x8 pa0, bf16x8 pa1, bf16x8 pa2, bf16x8 pa3) {
  s16x4 fa[8], fb[8];
  pv_rd<0>(fa, vb); pv_rd<1>(fb, vb);
  PV_WAIT(8, fa); pv_mm(o[0], fa, pa0, pa1, pa2, pa3);
  pv_rd<2>(fa, vb);
  PV_WAIT(8, fb); pv_mm(o[1], fb, pa0, pa1, pa2, pa3);
  pv_rd<3>(fb, vb);
  PV_WAIT(8, fa); pv_mm(o[2], fa, pa0, pa1, pa2, pa3);
  PV_WAIT(0, fb); pv_mm(o[3], fb, pa0, pa1, pa2, pa3);
}
#undef PV_WAIT
__device__ __forceinline__ void qkt(f32x16& p0, f32x16& p1, const char* Ks, const bf16x8* qr, const bf16x8* qs, const int* kb) {
  p0 = f32x16{}; p1 = f32x16{};
#pragma unroll
  for (int d0 = 0; d0 < 12; ++d0) { const int off = kb[d0 & 3] + (d0 >> 2) * 128;
    bf16x8 b0 = *reinterpret_cast<const bf16x8*>(Ks + off);
    bf16x8 b1 = *reinterpret_cast<const bf16x8*>(Ks + off + 32 * 384);
    const bf16x8 q = d0 < 8 ? qr[d0 < 8 ? d0 : 0] : qs[(d0 - 8) * 64];
    p0 = __builtin_amdgcn_mfma_f32_32x32x16_bf16(b0, q, p0, 0, 0, 0);
    p1 = __builtin_amdgcn_mfma_f32_32x32x16_bf16(b1, q, p1, 0, 0, 0); }
}
__device__ __forceinline__ unsigned short f2bf16(float f) { unsigned u = __builtin_bit_cast(unsigned, f); return (unsigned short)((u + 0x7fffu + ((u >> 16) & 1u)) >> 16); }
__device__ __forceinline__ void attn_unit(const bf16* __restrict__ Qb, const bf16* __restrict__ KN, const bf16* __restrict__ KR,
                                          bf16* __restrict__ Ob, int lat0, int nlat, int ctx0, int seq, char* lds,
                                          const float* __restrict__ qn_g, const float* __restrict__ qr_g, const float* __restrict__ rope, int npos0) {
  const int tid = tidx(), wid = tid >> 6, lane = tid & 63, r32 = lane & 31, hi = lane >> 5;
  char* V_lds = lds; char* K_lds = lds + 3 * SHM_V;
  float* ws = (float*)(lds + 3 * SHM_V + 3 * SHM_K) + wid * 64; float* li_l = ws; float* al_l = ws + 32;
  float m_reg = -1e30f, l_reg = 0; f32x16 o[4] = {}; bf16x8 qr[8];
  bf16x8* qs = (bf16x8*)(lds + QS_OFF) + wid * 4 * 64 + lane;
  const bf16* Qw = Qb + (long)(wid * QBLK + r32) * LDQ + hi * 8;
  {
    bf16x8 raw[12];
#pragma unroll
    for (int d0 = 0; d0 < 12; ++d0) raw[d0] = *reinterpret_cast<const bf16x8*>(Qw + d0 * 16);
    float ssn = 0.f, ssr = 0.f;
#pragma unroll
    for (int d0 = 0; d0 < 12; ++d0)
#pragma unroll
      for (int e = 0; e < 8; ++e) { const float v = __builtin_bit_cast(float, ((unsigned)(unsigned short)raw[d0][e]) << 16); if (d0 < 8) ssn += v * v; else ssr += v * v; }
    ssn += __shfl_xor(ssn, 32); ssr += __shfl_xor(ssr, 32);
    const float rsn = 1.0f / sqrtf(ssn * (1.0f / 128) + 1e-6f), rsr = 1.0f / sqrtf(ssr * (1.0f / 64) + 1e-6f);
#pragma unroll
    for (int d0 = 0; d0 < 8; ++d0) { u32x4 w;
#pragma unroll
      for (int e2 = 0; e2 < 4; ++e2) { const int d = d0 * 16 + hi * 8 + 2 * e2;
        const float v0 = __builtin_bit_cast(float, ((unsigned)(unsigned short)raw[d0][2 * e2]) << 16) * rsn * qn_g[d], v1 = __builtin_bit_cast(float, ((unsigned)(unsigned short)raw[d0][2 * e2 + 1]) << 16) * rsn * qn_g[d + 1];
        w[e2] = cvtpk(v0, v1); }
      qr[d0] = *reinterpret_cast<bf16x8*>(&w); }
    const int npos = npos0 < 0 ? -1 : npos0 + wid * QBLK + r32;
#pragma unroll
    for (int a = 0; a < 2; ++a) { u32x4 w0, w1; const int pos = a ? (npos & 63) : (npos >> 6);
#pragma unroll
      for (int e2 = 0; e2 < 4; ++e2) { float o0[2], o1[2];
#pragma unroll
        for (int t = 0; t < 2; ++t) { const int e = 2 * e2 + t, f = hi * 8 + e;
          const float x0 = __builtin_bit_cast(float, ((unsigned)(unsigned short)raw[8 + 2 * a][e]) << 16) * rsr * qr_g[a * 32 + f];
          const float x1 = __builtin_bit_cast(float, ((unsigned)(unsigned short)raw[9 + 2 * a][e]) << 16) * rsr * qr_g[a * 32 + 16 + f];
          float c = 1.f, sn = 0.f; if (npos >= 0) { c = rope[(pos * 16 + f) * 2]; sn = rope[(pos * 16 + f) * 2 + 1]; }
          o0[t] = x0 * c - x1 * sn; o1[t] = x1 * c + x0 * sn; }
        w0[e2] = cvtpk(o0[0], o0[1]); w1[e2] = cvtpk(o1[0], o1[1]); }
      qs[(2 * a) * 64] = *reinterpret_cast<bf16x8*>(&w0); qs[(2 * a + 1) * 64] = *reinterpret_cast<bf16x8*>(&w1); }
  }
  int kb[4];
#pragma unroll
  for (int j = 0; j < 4; ++j) kb[j] = r32 * 384 + ((j * 32 + hi * 16) ^ (((r32 >> 1) & 7) << 4));
  const int sr = tid >> 4, sc = (tid & 15) * 8, vst0 = v_st(sr, sc), vst1 = v_st(32 + sr, sc);
  const int knd0 = KSWZ(sr, sc * 2), knd1 = knd0 + 32 * 384, krd = KSWZ(tid >> 3, (16 + (tid & 7)) * 16);
  const int vb0 = (int)(uintptr_t)V_lds + v_rd_base(lane);
  bf16x8 vs0, vs1, ks0, ks1, ks2;
#define KROW(k0) (((k0) < nlat) ? lat0 + (k0) : ctx0 + (k0) - nlat)
#define SLOAD(k0) do { const long rb = KROW(k0); const bf16* pn = KN + (rb + sr) * LDKN + sc; \
    ks0 = *reinterpret_cast<const bf16x8*>(pn); ks1 = *reinterpret_cast<const bf16x8*>(pn + 32 * LDKN); vs0 = *reinterpret_cast<const bf16x8*>(pn + 128); vs1 = *reinterpret_cast<const bf16x8*>(pn + 32 * LDKN + 128); \
    ks2 = *reinterpret_cast<const bf16x8*>(KR + rb * LDKR + tid * 8); } while (0)
#define SWRITE(b) do { *(bf16x8*)(V_lds + (b) * SHM_V + vst0) = vs0; *(bf16x8*)(V_lds + (b) * SHM_V + vst1) = vs1; \
    *(bf16x8*)(K_lds + (b) * SHM_K + knd0) = ks0; *(bf16x8*)(K_lds + (b) * SHM_K + knd1) = ks1; *(bf16x8*)(K_lds + (b) * SHM_K + krd) = ks2; } while (0)
#define SWAIT() asm volatile("s_waitcnt vmcnt(0)" ::: "memory")
#define RESC(a) do { if (__any((a) < 1.f)) { if (hi == 0) al_l[r32] = (a); asm volatile("s_waitcnt lgkmcnt(0)" ::: "memory"); \
    for (int d = 0; d < 4; ++d) for (int r = 0; r < 16; ++r) o[d][r] *= al_l[crow(r, hi)]; } } while (0)
  f32x16 pA0, pA1, pB0, pB1; float mnA, mnB, alA, alB; bf16x8 pa0, pa1, pa2, pa3; const int NT = seq / KVBLK;
  SLOAD(0); SWAIT(); SWRITE(0); __syncthreads();
  qkt(pA0, pA1, K_lds, qr, qs, kb); partialSM(pA0, pA1, m_reg, mnA, alA);
  SLOAD(KVBLK); SWAIT(); SWRITE(1); __syncthreads();
  int rp = 0, rc = 1, rn = 2;
  for (int j = 1; j + 1 < NT; j += 2) {
    SBAR(); qkt(pB0, pB1, K_lds + rc * SHM_K, qr, qs, kb);
    finishSM(pA0, pA1, alA, l_reg, pa0, pa1, pa2, pa3); SBAR();
    SLOAD((j + 1) * KVBLK); SBAR();
    pv_d0(o, vb0 + rp * SHM_V, pa0, pa1, pa2, pa3); partialSM(pB0, pB1, m_reg, mnB, alB);
    SWRITE(rn);
    RESC(alB); __syncthreads();
    { const int t = rp; rp = rc; rc = rn; rn = t; }
    SBAR(); qkt(pA0, pA1, K_lds + rc * SHM_K, qr, qs, kb);
    finishSM(pB0, pB1, alB, l_reg, pa0, pa1, pa2, pa3); SBAR();
    SLOAD((j + 2) * KVBLK); SBAR();
    pv_d0(o, vb0 + rp * SHM_V, pa0, pa1, pa2, pa3); partialSM(pA0, pA1, m_reg, mnA, alA);
    SWRITE(rn);
    RESC(alA); __syncthreads();
    { const int t = rp; rp = rc; rc = rn; rn = t; }
  }
  SBAR(); qkt(pB0, pB1, K_lds + rc * SHM_K, qr, qs, kb);
  finishSM(pA0, pA1, alA, l_reg, pa0, pa1, pa2, pa3); SBAR();
  pv_d0(o, vb0 + rp * SHM_V, pa0, pa1, pa2, pa3); partialSM(pB0, pB1, m_reg, mnB, alB);
  RESC(alB);
  finishSM(pB0, pB1, alB, l_reg, pa0, pa1, pa2, pa3); SBAR();
  pv_d0(o, vb0 + rc * SHM_V, pa0, pa1, pa2, pa3);
  if (hi == 0) li_l[r32] = l_reg; asm volatile("s_waitcnt lgkmcnt(0)" ::: "memory");
  float rli[16];
#pragma unroll
  for (int r = 0; r < 16; ++r) rli[r] = __builtin_amdgcn_rcpf(li_l[crow(r, hi)]);
  bf16* Ow = Ob + (long)(wid * QBLK) * LDO;
#pragma unroll
  for (int r = 0; r < 16; ++r) { const int orow = crow(r, hi);
#pragma unroll
    for (int d0 = 0; d0 < 4; ++d0) Ow[(long)orow * LDO + d0 * 32 + r32] = f2bf16(o[d0][r] * rli[r]); }
#undef KROW
#undef SLOAD
#undef SWRITE
#undef SWAIT
#undef RESC
}
#undef SBAR
#undef KSWZ
}
#define LAS __attribute__((address_space(3)))
typedef unsigned short bf16;
typedef unsigned v4u __attribute__((ext_vector_type(4)));
typedef unsigned v2u __attribute__((ext_vector_type(2)));
typedef float f32x4 __attribute__((ext_vector_type(4)));
constexpr size_t MiB = 1u << 20;
constexpr size_t WS_MOD = 0, WS_ROPE = 1 * MiB, WS_XC = 2 * MiB, WS_W = 6 * MiB, WS_H = 96 * MiB, WS_Y = 162 * MiB, WS_QL = 261 * MiB, WS_KVL = 278 * MiB,
                 WS_Q = 287 * MiB, WS_KV = 337 * MiB, WS_KR = 403 * MiB, WS_MIX = 408 * MiB, WS_EDGE = 408 * MiB, WS_HID = 162 * MiB, WS_END = 506 * MiB;
constexpr size_t WO_IN = 0, WO_Q = WO_IN + (size_t)INP * DM, WO_KV = WO_Q + (size_t)768 * QRK, WO_O = WO_KV + (size_t)1024 * KVRK, WO_UP = WO_O + (size_t)DM * DM,
                 WO_DN = WO_UP + (size_t)2 * DFF * DM, W_LAYER = WO_DN + (size_t)DM * DFF;
static_assert(WS_W + W_LAYER * 2 * DEPTH <= WS_H && WS_H + (size_t)TT * DM * 2 <= WS_Y && WS_Y + (size_t)TT * INP * 2 <= WS_QL && WS_QL + (size_t)TT * QRK * 2 <= WS_KVL &&
              WS_KVL + (size_t)TT * KVRK * 2 <= WS_Q && WS_Q + (size_t)TT * 768 * 2 <= WS_KV && WS_KV + (size_t)TT * 1024 * 2 <= WS_KR && WS_KR + (size_t)TT * 64 * 2 <= WS_MIX &&
              WS_MIX + (size_t)TT * DM * 2 <= 474 * MiB && WS_EDGE + (size_t)3 * (TT / 64) * 2 * DFF * 4 <= 474 * MiB && WS_HID + (size_t)TT * DFF * 2 <= WS_KR, "d_ws map");
constexpr size_t WS_PART_WO = 344 * MiB;
constexpr size_t WS_PART_DN = 408 * MiB;
constexpr size_t WS_X1A = 376 * MiB, WS_X1B = 474 * MiB;
constexpr int X1_SPLIT = 16384;
static_assert(WS_PART_WO >= WS_HID + (size_t)TT * DFF * 2 && WS_PART_WO + (size_t)8 * TCTX * DM * 4 <= WS_X1A && WS_X1A + (size_t)X1_SPLIT * DM * 2 <= WS_MIX &&
              WS_PART_DN + (size_t)11 * TCTX * DM * 4 <= 474 * MiB && WS_X1B + (size_t)(TLAT - X1_SPLIT) * DM * 2 <= WS_END, "slabs and x1 map");
constexpr size_t EDGE_N = (size_t)(TT / 64) * 2 * DFF;
constexpr int LDS_BYTES = 163840, LDS_ST_OFF = LDS_BYTES - 64;
constexpr size_t WS_BAR = WS_ROPE + 512 * 1024;
constexpr int NPH = 1 + 10 * DEPTH;
constexpr int NCTXU = (TCTX / 256) * (INP / 256);
static_assert(att::ATTN_LDS <= LDS_ST_OFF, "attention LDS map below the barrier words");

__device__ __forceinline__ unsigned f2bf(float f) { unsigned u = __builtin_bit_cast(unsigned, f); return (u + 0x7fffu + ((u >> 16) & 1u)) >> 16; }
__device__ __forceinline__ unsigned pk2(float lo, float hi) { typedef float f32x2_c __attribute__((ext_vector_type(2))); typedef __bf16 bf16x2_c __attribute__((ext_vector_type(2)));
    const f32x2_c v = {lo, hi}; const bf16x2_c b = __builtin_convertvector(v, bf16x2_c); return __builtin_bit_cast(unsigned, b); }
__device__ __forceinline__ float bflo(unsigned w) { return __builtin_bit_cast(float, w << 16); }
__device__ __forceinline__ float bfhi(unsigned w) { return __builtin_bit_cast(float, w & 0xffff0000u); }
__device__ __forceinline__ float wave_sum(float v) {
    v += __builtin_bit_cast(float, __builtin_amdgcn_update_dpp(0, __builtin_bit_cast(int, v), 0xB1, 0xF, 0xF, true));
    v += __builtin_bit_cast(float, __builtin_amdgcn_update_dpp(0, __builtin_bit_cast(int, v), 0x4E, 0xF, 0xF, true));
    v += __builtin_bit_cast(float, __builtin_amdgcn_update_dpp(0, __builtin_bit_cast(int, v), 0x141, 0xF, 0xF, true));
    v += __builtin_bit_cast(float, __builtin_amdgcn_update_dpp(0, __builtin_bit_cast(int, v), 0x140, 0xF, 0xF, true));
    const float r0 = __builtin_bit_cast(float, __builtin_amdgcn_readlane(__builtin_bit_cast(int, v), 0)), r1 = __builtin_bit_cast(float, __builtin_amdgcn_readlane(__builtin_bit_cast(int, v), 16));
    const float r2 = __builtin_bit_cast(float, __builtin_amdgcn_readlane(__builtin_bit_cast(int, v), 32)), r3 = __builtin_bit_cast(float, __builtin_amdgcn_readlane(__builtin_bit_cast(int, v), 48));
    v = (r0 + r1) + (r2 + r3);
    return v;
}
#define LDS_WAIT() asm volatile("s_waitcnt lgkmcnt(0)" ::: "memory")

#define XB_TMO      128
#define XB_XCNT(j)  (256  + 64 * (j))
#define XB_XSUB(j)  (1280 + 64 * (j))
#define XB_XGEN(j)  (2304 + 64 * (j))
#define XB_TOP      3328
#define XB_TOPGEN   3392
#define XCD_BAR_WORDS 3456
#define XB_SPIN_CAP (1u << 18)

__device__ __forceinline__ unsigned xb_ld(unsigned* p)              { return __hip_atomic_load(p, __ATOMIC_RELAXED, __HIP_MEMORY_SCOPE_AGENT); }
__device__ __forceinline__ unsigned xb_add(unsigned* p, unsigned v) { return __hip_atomic_fetch_add(p, v, __ATOMIC_RELAXED, __HIP_MEMORY_SCOPE_AGENT); }
__device__ __forceinline__ unsigned xb_xcc_id() { return (unsigned)__builtin_amdgcn_s_getreg((3 << 11) | 20) & 0xFu; }
#define XB_SPIN(cond, bar) do { unsigned _sp = 0; while (cond) { __builtin_amdgcn_s_sleep(1); \
    if ((++_sp & 255u) == 0u) { if (xb_ld(&(bar)[XB_TMO])) break; if (_sp > XB_SPIN_CAP) { atomicAdd(&(bar)[XB_TMO], 1u); break; } } } } while (0)

struct XcdBarrier {
    unsigned* bar; unsigned x;
    volatile LAS unsigned* st;
};

__device__ __forceinline__ XcdBarrier xcd_barrier_post(unsigned* bar, volatile LAS unsigned* st) {
    XcdBarrier b; b.bar = bar; b.x = xb_xcc_id(); b.st = st;
    if (tidx() == 0) (void)xb_add(&bar[XB_XCNT(b.x)], 1u);
    return b;
}
__device__ __forceinline__ void xcd_barrier_complete(unsigned* bar, unsigned x, unsigned& nloc, unsigned& nx) {
    const unsigned G = gridDim.x * gridDim.y * gridDim.z;
    unsigned sum, cnt, mine, sp = 0u;
    for (;;) {
        sum = 0u; cnt = 0u; mine = 0u;
#pragma unroll
        for (unsigned j = 0; j < 16; ++j) { const unsigned c = xb_ld(&bar[XB_XCNT(j)]); sum += c; cnt += (c > 0u) ? 1u : 0u; mine = (j == x) ? c : mine; }
        if (sum == G) break;
        __builtin_amdgcn_s_sleep(1);
        if ((++sp & 255u) == 0u) { if (xb_ld(&bar[XB_TMO])) break; if (sp > XB_SPIN_CAP) { atomicAdd(&bar[XB_TMO], 1u); break; } }
    }
    nloc = mine > 0u ? mine : 1u; nx = cnt > 0u ? cnt : 1u;
}

__device__ __forceinline__ void xcd_barrier(const XcdBarrier& b) {
    asm volatile("s_waitcnt vmcnt(0)" ::: "memory");
    __syncthreads();
    if (tidx() == 0) {
        unsigned* bar = b.bar;
        __builtin_amdgcn_s_waitcnt(0);
        unsigned nloc = b.st[0], nx = b.st[1];
        if (nloc == 0u) { xcd_barrier_complete(bar, b.x, nloc, nx); b.st[0] = nloc; b.st[1] = nx; }
        const unsigned old = xb_add(&bar[XB_XSUB(b.x)], 1u);
        const unsigned gen = old / nloc;
        if (old + 1u == (gen + 1u) * nloc) {
            __builtin_amdgcn_fence(__ATOMIC_RELEASE, "agent");
            asm volatile("s_waitcnt vmcnt(0)" ::: "memory");
            const unsigned og = xb_add(&bar[XB_TOP], 1u);
            const unsigned tg = og / nx;
            if (og + 1u == (tg + 1u) * nx) xb_add(&bar[XB_TOPGEN], 1u);
            else XB_SPIN(xb_ld(&bar[XB_TOPGEN]) == tg, bar);
            __builtin_amdgcn_fence(__ATOMIC_ACQUIRE, "agent");
            xb_add(&bar[XB_XGEN(b.x)], 1u);
            asm volatile("s_waitcnt vmcnt(0)" ::: "memory");
        } else {
            XB_SPIN(xb_ld(&bar[XB_XGEN(b.x)]) == gen, bar);
            __builtin_amdgcn_fence(__ATOMIC_ACQUIRE, "agent");
            asm volatile("s_waitcnt vmcnt(0)" ::: "memory");
        }
    }
    __syncthreads();
}

struct Params { const float* in[24]; float* out; unsigned char* ws; int ph_lo, ph_hi; };
typedef const Params __attribute__((address_space(4))) CParams;
namespace pg8 {
__device__ __forceinline__ unsigned f2bf(float f) { unsigned u = __builtin_bit_cast(unsigned, f); return (u + 0x7fffu + ((u >> 16) & 1u)) >> 16; }
__device__ __forceinline__ unsigned pk2(float lo, float hi) { typedef float f32x2_c __attribute__((ext_vector_type(2))); typedef __bf16 bf16x2_c __attribute__((ext_vector_type(2)));
    const f32x2_c v = {lo, hi}; const bf16x2_c b = __builtin_convertvector(v, bf16x2_c); return __builtin_bit_cast(unsigned, b); }
struct EpiStore {
    static constexpr bool PERM = true, AFTER_DRAIN = false;
    bf16_t* O; int ldc;
    __device__ __forceinline__ void operator()(const f32x4 (&acc)[2][2][4][2], const Unit& u, int wr, int wc, int fr, int fq) const {
        const int row0 = u.pm * BM + wr * 64 + fr, col0 = u.pn * BM + wc * 32 + 8 * fq;
#pragma unroll
        for (int ai = 0; ai < 2; ++ai)
#pragma unroll
            for (int m = 0; m < 4; ++m) { bf16_t* rowp = O + (size_t)(row0 + ai * HALF + m * 16) * ldc + col0;
#pragma unroll
                for (int bj = 0; bj < 2; ++bj) { const f32x4 v0 = acc[ai][bj][m][0], v1 = acc[ai][bj][m][1];
                    u32x4 w; w.x = pk2(v0[0], v0[1]); w.y = pk2(v0[2], v0[3]); w.z = pk2(v1[0], v1[1]); w.w = pk2(v1[2], v1[3]);
                    *(u32x4*)(rowp + bj * HALF) = w; } }
    }
};
struct EpiKv {
    static constexpr bool PERM = true, AFTER_DRAIN = false;
    bf16_t* O; const float* kn_g; __attribute__((address_space(3))) float* X;
    __device__ __forceinline__ void operator()(const f32x4 (&acc)[2][2][4][2], const Unit& u, int wr, int wc, int fr, int fq) const {
        const int row0 = u.pm * BM + wr * 64 + fr, col0 = u.pn * BM + wc * 32 + 8 * fq;
        float ss[2][4];
#pragma unroll
        for (int ai = 0; ai < 2; ++ai)
#pragma unroll
            for (int m = 0; m < 4; ++m) { const f32x4 a = acc[ai][0][m][0], b = acc[ai][0][m][1];
                float s = ((a[0] * a[0] + a[1] * a[1]) + (a[2] * a[2] + a[3] * a[3])) + ((b[0] * b[0] + b[1] * b[1]) + (b[2] * b[2] + b[3] * b[3]));
                s += __shfl_xor(s, 16); s += __shfl_xor(s, 32);
                ss[ai][m] = s; }
        if (fq == 0) {
#pragma unroll
            for (int ai = 0; ai < 2; ++ai)
#pragma unroll
                for (int m = 0; m < 4; ++m) X[(ai * HALF + wr * 64 + m * 16 + fr) * 4 + wc] = ss[ai][m]; }
        asm volatile("s_waitcnt lgkmcnt(0)" ::: "memory"); __builtin_amdgcn_s_barrier(); asm volatile("" ::: "memory");
        const f32x4 g0 = *(const f32x4*)(kn_g + wc * 32 + 8 * fq), g1 = *(const f32x4*)(kn_g + wc * 32 + 8 * fq + 4);
#pragma unroll
        for (int ai = 0; ai < 2; ++ai)
#pragma unroll
            for (int m = 0; m < 4; ++m) { bf16_t* rowp = O + (size_t)(row0 + ai * HALF + m * 16) * 1024 + col0;
                const f32x4 xp = *(const __attribute__((address_space(3))) f32x4*)(X + (ai * HALF + wr * 64 + m * 16 + fr) * 4);
                const float rs = 1.0f / sqrtf(((xp[0] + xp[1]) + (xp[2] + xp[3])) * (1.0f / 128) + EPSN);
                { const f32x4 v0 = acc[ai][0][m][0] * rs * g0, v1 = acc[ai][0][m][1] * rs * g1;
                  u32x4 w; w.x = pk2(v0[0], v0[1]); w.y = pk2(v0[2], v0[3]); w.z = pk2(v1[0], v1[1]); w.w = pk2(v1[2], v1[3]); *(u32x4*)(rowp) = w; }
                { const f32x4 v0 = acc[ai][1][m][0], v1 = acc[ai][1][m][1];
                  u32x4 w; w.x = pk2(v0[0], v0[1]); w.y = pk2(v0[2], v0[3]); w.z = pk2(v1[0], v1[1]); w.w = pk2(v1[2], v1[3]); *(u32x4*)(rowp + HALF) = w; } }
    }
};
struct EpiIn {
    static constexpr bool PERM = true, AFTER_DRAIN = false;
    unsigned char* ws; const float* qc_g; const float* kvc_g; const float* kr_g; __attribute__((address_space(3))) float* X;
    __device__ __forceinline__ void operator()(const f32x4 (&acc)[2][2][4][2], const Unit& u, int wr, int wc, int fr, int fq) const {
        bf16_t* Y = (bf16_t*)(ws + WS_Y);
        const int row0 = u.pm * BM + wr * 64 + fr;
        if (u.pn >= 2) { EpiStore E{Y, INP}; E(acc, u, wr, wc, fr, fq); return; }
#pragma unroll
        for (int ai = 0; ai < 2; ++ai)
#pragma unroll
            for (int m = 0; m < 4; ++m) {
                float s[2];
#pragma unroll
                for (int bj = 0; bj < 2; ++bj) { const f32x4 a = acc[ai][bj][m][0], b = acc[ai][bj][m][1];
                    float t = ((a[0] * a[0] + a[1] * a[1]) + (a[2] * a[2] + a[3] * a[3])) + ((b[0] * b[0] + b[1] * b[1]) + (b[2] * b[2] + b[3] * b[3]));
                    t += __shfl_xor(t, 16); t += __shfl_xor(t, 32); s[bj] = t; }
                if (fq == 0) { const int xr = (ai * HALF + wr * 64 + m * 16 + fr) * 8; X[xr + wc] = s[0]; X[xr + 4 + wc] = s[1]; } }
        asm volatile("s_waitcnt lgkmcnt(0)" ::: "memory"); __builtin_amdgcn_s_barrier(); asm volatile("" ::: "memory");
        const int c8 = wc * 32 + 8 * fq;
        if (u.pn == 0) {
            bf16_t* QLp = (bf16_t*)(ws + WS_QL);
            f32x4 g[2][2];
#pragma unroll
            for (int bj = 0; bj < 2; ++bj) { g[bj][0] = *(const f32x4*)(qc_g + bj * HALF + c8); g[bj][1] = *(const f32x4*)(qc_g + bj * HALF + c8 + 4); }
#pragma unroll
            for (int ai = 0; ai < 2; ++ai)
#pragma unroll
                for (int m = 0; m < 4; ++m) { const int lr = ai * HALF + wr * 64 + m * 16 + fr;
                    const f32x4 xa = *(const __attribute__((address_space(3))) f32x4*)(X + lr * 8), xb = *(const __attribute__((address_space(3))) f32x4*)(X + lr * 8 + 4);
                    const float rs = 1.0f / sqrtf((((xa[0] + xa[1]) + (xa[2] + xa[3])) + ((xb[0] + xb[1]) + (xb[2] + xb[3]))) * (1.0f / QRK) + EPSN);
                    bf16_t* rowp = QLp + (size_t)(row0 + ai * HALF + m * 16) * QRK + c8;
#pragma unroll
                    for (int bj = 0; bj < 2; ++bj) { const f32x4 v0 = acc[ai][bj][m][0] * rs * g[bj][0], v1 = acc[ai][bj][m][1] * rs * g[bj][1];
                        u32x4 w; w.x = pk2(v0[0], v0[1]); w.y = pk2(v0[2], v0[3]); w.z = pk2(v1[0], v1[1]); w.w = pk2(v1[2], v1[3]); *(u32x4*)(rowp + bj * HALF) = w; } }
        } else {
            bf16_t* KVLp = (bf16_t*)(ws + WS_KVL); bf16_t* KRp = (bf16_t*)(ws + WS_KR); const float* rope = (const float*)(ws + WS_ROPE);
            const f32x4 gk0 = *(const f32x4*)(kvc_g + c8), gk1 = *(const f32x4*)(kvc_g + c8 + 4);
            const bool lat = u.pm * BM < TLAT;
#pragma unroll
            for (int ai = 0; ai < 2; ++ai)
#pragma unroll
                for (int m = 0; m < 4; ++m) { const int lr = ai * HALF + wr * 64 + m * 16 + fr; const int row = row0 + ai * HALF + m * 16;
                    const f32x4 xa = *(const __attribute__((address_space(3))) f32x4*)(X + lr * 8), xb = *(const __attribute__((address_space(3))) f32x4*)(X + lr * 8 + 4);
                    { const float rs = 1.0f / sqrtf(((xa[0] + xa[1]) + (xa[2] + xa[3])) * (1.0f / KVRK) + EPSN);
                      const f32x4 v0 = acc[ai][0][m][0] * rs * gk0, v1 = acc[ai][0][m][1] * rs * gk1;
                      u32x4 w; w.x = pk2(v0[0], v0[1]); w.y = pk2(v0[2], v0[3]); w.z = pk2(v1[0], v1[1]); w.w = pk2(v1[2], v1[3]); *(u32x4*)(KVLp + (size_t)row * KVRK + c8) = w; }
                    if (wc < 2) {
                        const float rs = 1.0f / sqrtf((xb[0] + xb[1]) * (1.0f / 64) + EPSN);
                        const f32x4 gr0 = *(const f32x4*)(kr_g + c8), gr1 = *(const f32x4*)(kr_g + c8 + 4);
                        f32x4 v0 = acc[ai][1][m][0] * rs * gr0, v1 = acc[ai][1][m][1] * rs * gr1;
                        f32x4 p0, p1;
#pragma unroll
                        for (int e = 0; e < 4; ++e) { p0[e] = __shfl_xor(v0[e], 32); p1[e] = __shfl_xor(v1[e], 32); }
                        if (lat) { const int n = row & (SEQ - 1); const int pos = wc ? (n & 63) : (n >> 6); const float* rt = rope + (size_t)(pos * 16 + (fq & 1) * 8) * 2; const float sg = (fq >> 1) ? 1.f : -1.f;
                            const f32x4 t0 = *(const f32x4*)(rt), t1 = *(const f32x4*)(rt + 4), t2 = *(const f32x4*)(rt + 8), t3 = *(const f32x4*)(rt + 12);
                            v0 = (f32x4){v0[0] * t0[0] + sg * p0[0] * t0[1], v0[1] * t0[2] + sg * p0[1] * t0[3], v0[2] * t1[0] + sg * p0[2] * t1[1], v0[3] * t1[2] + sg * p0[3] * t1[3]};
                            v1 = (f32x4){v1[0] * t2[0] + sg * p1[0] * t2[1], v1[1] * t2[2] + sg * p1[1] * t2[3], v1[2] * t3[0] + sg * p1[2] * t3[1], v1[3] * t3[2] + sg * p1[3] * t3[3]}; }
                        u32x4 w; w.x = pk2(v0[0], v0[1]); w.y = pk2(v0[2], v0[3]); w.z = pk2(v1[0], v1[1]); w.w = pk2(v1[2], v1[3]); *(u32x4*)(KRp + (size_t)row * 64 + c8) = w;
                    } else {
                        const f32x4 v0 = acc[ai][1][m][0], v1 = acc[ai][1][m][1];
                        u32x4 w; w.x = pk2(v0[0], v0[1]); w.y = pk2(v0[2], v0[3]); w.z = pk2(v1[0], v1[1]); w.w = pk2(v1[2], v1[3]); *(u32x4*)(Y + (size_t)row * INP + 384 + c8) = w; } }
        }
    }
};
struct EpiResid {
    static constexpr bool PERM = true, AFTER_DRAIN = false;
    const float* xin_lat; const float* xin_ctx; float* out_lat; float* out_ctx; const float* modL; int gate_chunk;
    bf16_t* x1a; bf16_t* x1b; int flags;
    __device__ __forceinline__ void operator()(const f32x4 (&acc)[2][2][4][2], const Unit& u, int wr, int wc, int fr, int fq) const {
        const int rowt = u.pm * BM; const bool lat = rowt < TLAT;
        const int j = lat ? rowt / SEQ : 4;
        const float* gate = modL + j * 6144 + gate_chunk * 1024;
        const float* xin = lat ? xin_lat + (size_t)rowt * DM : xin_ctx + (size_t)(rowt - TLAT) * DM;
        float* xo = lat ? out_lat + (size_t)rowt * DM : out_ctx + (size_t)(rowt - TLAT) * DM;
        const int col0 = u.pn * BM + wc * 32 + 8 * fq;
        typedef unsigned u32x2 __attribute__((ext_vector_type(2)));
        bf16_t* x1p = rowt < X1_SPLIT ? x1a + (size_t)rowt * DM : x1b + (size_t)(rowt - X1_SPLIT) * DM;
        f32x4 gv[2][2];
#pragma unroll
        for (int bj = 0; bj < 2; ++bj)
#pragma unroll
            for (int n = 0; n < 2; ++n) gv[bj][n] = *(const f32x4*)(gate + col0 + bj * HALF + 4 * n);
        f32x4 xa[2][2][2], xb[2][2][2];
#define RES_LOAD(dst, p) do { _Pragma("unroll") for (int g_ = 0; g_ < 2; ++g_) { const int gi_ = (p) * 2 + g_, ai_ = gi_ >> 2, m_ = gi_ & 3; const size_t off_ = (size_t)(wr * 64 + fr + ai_ * HALF + m_ * 16) * DM + col0; \
            _Pragma("unroll") for (int bj = 0; bj < 2; ++bj) _Pragma("unroll") for (int n = 0; n < 2; ++n) { if (flags & 1) { const u32x2 w_ = *(const u32x2*)(x1p + off_ + bj * HALF + 4 * n); dst[g_][bj][n] = (f32x4){__builtin_bit_cast(float, w_.x << 16), __builtin_bit_cast(float, w_.x & 0xffff0000u), __builtin_bit_cast(float, w_.y << 16), __builtin_bit_cast(float, w_.y & 0xffff0000u)}; } \
              else dst[g_][bj][n] = *(const f32x4*)(xin + off_ + bj * HALF + 4 * n); } } } while (0)
#define RES_STORE(src, p) do { _Pragma("unroll") for (int g_ = 0; g_ < 2; ++g_) { const int gi_ = (p) * 2 + g_, ai_ = gi_ >> 2, m_ = gi_ & 3; const size_t off_ = (size_t)(wr * 64 + fr + ai_ * HALF + m_ * 16) * DM + col0; \
            _Pragma("unroll") for (int bj = 0; bj < 2; ++bj) _Pragma("unroll") for (int n = 0; n < 2; ++n) { const f32x4 r_ = src[g_][bj][n] + gv[bj][n] * acc[ai_][bj][m_][n]; \
              if (flags & 2) { u32x2 w_; w_.x = pk2(r_.x, r_.y); w_.y = pk2(r_.z, r_.w); *(u32x2*)(x1p + off_ + bj * HALF + 4 * n) = w_; } else *(f32x4*)(xo + off_ + bj * HALF + 4 * n) = r_; } } } while (0)
        RES_LOAD(xa, 0);
        RES_LOAD(xb, 1); RES_STORE(xa, 0);
        RES_LOAD(xa, 2); RES_STORE(xb, 1);
        RES_LOAD(xb, 3); RES_STORE(xa, 2);
        RES_STORE(xb, 3);
#undef RES_LOAD
#undef RES_STORE
    }
};
struct EpiFfUp {
    static constexpr bool PERM = true, AFTER_DRAIN = false;
    bf16_t* HID; const float* cw; float* GE; float* PE; float* UE;
    __device__ __forceinline__ void operator()(const f32x4 (&acc)[2][2][4][2], const Unit& u, int wr, int wc, int fr, int fq) const {
        const int ch0 = u.pn * HALF + wc * 32 + 8 * fq;
        f32x4 w0[2], w1[2], w2[2];
#pragma unroll
        for (int n = 0; n < 2; ++n) { w0[n] = *(const f32x4*)(cw + ch0 + 4 * n); w1[n] = *(const f32x4*)(cw + DFF + ch0 + 4 * n); w2[n] = *(const f32x4*)(cw + 2 * DFF + ch0 + 4 * n); }
#pragma unroll
        for (int ai = 0; ai < 2; ++ai) {
            const int blk = u.pm * 4 + ai * 2 + wr; const int rowb = u.pm * BM + ai * HALF + wr * 64;
#pragma unroll
            for (int m = 0; m < 4; ++m) {
                float hv[8], cv[8];
#pragma unroll
                for (int n = 0; n < 2; ++n)
#pragma unroll
                    for (int e = 0; e < 4; ++e) {
                        const float g = acc[ai][0][m][n][e];
                        const float gprev = (m > 0) ? acc[ai][0][m > 0 ? m - 1 : 0][n][e] : 0.f;
                        const float gnext = (m < 3) ? acc[ai][0][m < 3 ? m + 1 : 3][n][e] : 0.f;
                        const float up = __builtin_bit_cast(float, __builtin_amdgcn_update_dpp(0, __builtin_bit_cast(int, (fr == 15) ? gprev : g), 0x121, 0xF, 0xF, true));
                        const float dn = __builtin_bit_cast(float, __builtin_amdgcn_update_dpp(0, __builtin_bit_cast(int, (fr == 0) ? gnext : g), 0x12F, 0xF, 0xF, true));
                        const float conv = w0[n][e] * up + w1[n][e] * g + w2[n][e] * dn;
                        cv[4 * n + e] = conv;
                        hv[4 * n + e] = conv * __builtin_amdgcn_rcpf(1.f + __expf(-conv)) * acc[ai][1][m][n][e];
                    }
                u32x4 w; w.x = pk2(hv[0], hv[1]); w.y = pk2(hv[2], hv[3]); w.z = pk2(hv[4], hv[5]); w.w = pk2(hv[6], hv[7]);
                *(u32x4*)(HID + (size_t)(rowb + m * 16 + fr) * DFF + ch0) = w;
                if ((m == 0 && fr == 0) || (m == 3 && fr == 15)) {
                    const size_t eo = ((size_t)blk * 2 + (m == 0 ? 0 : 1)) * DFF + ch0;
#pragma unroll
                    for (int n = 0; n < 2; ++n) { *(f32x4*)(GE + eo + 4 * n) = acc[ai][0][m][n]; *(f32x4*)(UE + eo + 4 * n) = acc[ai][1][m][n];
                        *(f32x4*)(PE + eo + 4 * n) = (f32x4){cv[4 * n], cv[4 * n + 1], cv[4 * n + 2], cv[4 * n + 3]}; }
                }
            }
        }
    }
};
struct EpiPartial {
    static constexpr bool PERM = true, AFTER_DRAIN = false;
    float* P;
    __device__ __forceinline__ void operator()(const f32x4 (&acc)[2][2][4][2], const Unit& u, int wr, int wc, int fr, int fq) const {
        float* xo = P + ((size_t)u.ks * TCTX + (size_t)(u.pm * BM - TLAT)) * DM; const int col0 = u.pn * BM + wc * 32 + 8 * fq;
#pragma unroll
        for (int ai = 0; ai < 2; ++ai)
#pragma unroll
            for (int m = 0; m < 4; ++m) { const size_t off = (size_t)(wr * 64 + fr + ai * HALF + m * 16) * DM + col0;
#pragma unroll
                for (int bj = 0; bj < 2; ++bj)
#pragma unroll
                    for (int n = 0; n < 2; ++n) *(f32x4*)(xo + off + bj * HALF + 4 * n) = acc[ai][bj][m][n]; }
    }
};
struct EpiAll {
    static constexpr bool PERM = true, AFTER_DRAIN = false;
    int mode, ldc; const void* a0; const void* a1; const void* a2; const void* a3; const void* a4; const void* x1a; const void* x1b;
    __device__ __forceinline__ void operator()(const f32x4 (&acc)[2][2][4][2], const Unit& u, int wr, int wc, int fr_, int fq_) const {
        int ln = (int)__builtin_amdgcn_mbcnt_hi(~0u, __builtin_amdgcn_mbcnt_lo(~0u, 0u)); asm volatile("" : "+v"(ln));
        const int fr = ln & 15, fq = ln >> 4; (void)fr_; (void)fq_;
        if (mode == 0) { EpiStore E{(bf16_t*)a0, ldc}; E(acc, u, wr, wc, fr, fq); }
        else if (mode == 1) { EpiResid E{(const float*)a0, (const float*)a1, (float*)a2, (float*)a3, (const float*)a4, 0, (bf16_t*)x1a, (bf16_t*)x1b, ldc}; E(acc, u, wr, wc, fr, fq); }
        else if (mode == 2) { EpiFfUp E{(bf16_t*)a0, (const float*)a1, (float*)a2, (float*)a2 + EDGE_N, (float*)a2 + 2 * EDGE_N}; E(acc, u, wr, wc, fr, fq); }
        else if (mode == 3) { EpiPartial E{(float*)a3}; E(acc, u, wr, wc, fr, fq); }
        else if (mode == 4) { EpiKv E{(bf16_t*)a0, (const float*)a1, (__attribute__((address_space(3))) float*)(131072u)}; E(acc, u, wr, wc, fr, fq); }
        else { EpiIn E{(unsigned char*)a0, (const float*)a1, (const float*)a2, (const float*)a3, (__attribute__((address_space(3))) float*)(131072u)}; E(acc, u, wr, wc, fr, fq); }
    }
};
}

__device__ __forceinline__ void tr_item(const float* W, int N, int k0, int n0, bf16* WT, int Kd, int dst_row0, LAS float* scr, int lane, bool fold, const float* pw, const float* ps) {
#pragma unroll 8
    for (int i = 0; i < 32; ++i) { const int kk = 2 * i + (lane >> 5); scr[kk * 33 + (lane & 31)] = W[(size_t)(k0 + kk) * N + n0 + (lane & 31)]; }
    LDS_WAIT(); asm volatile("" ::: "memory");
    if (fold) {
        const int n = lane & 31, c0 = (lane >> 5) * 32; float res[32];
#pragma unroll
        for (int cc = 0; cc < 32; ++cc) res[cc] = 0.f;
        for (int d = 0; d < 64; ++d) { const float s = scr[d * 33 + n] * ps[d];
#pragma unroll
            for (int cc = 0; cc < 32; ++cc) res[cc] += pw[(c0 + cc) * 64 + d] * s; }
        LDS_WAIT(); asm volatile("" ::: "memory");
#pragma unroll
        for (int cc = 0; cc < 32; ++cc) scr[(c0 + cc) * 33 + n] = res[cc];
        LDS_WAIT(); asm volatile("" ::: "memory");
    }
    const int c = lane & 7;
#pragma unroll
    for (int j = 0; j < 4; ++j) { const int n = (lane >> 3) + 8 * j; const LAS float* s = scr + (8 * c) * 33 + n;
        v4u o; o.x = pk2(s[0 * 33], s[1 * 33]); o.y = pk2(s[2 * 33], s[3 * 33]); o.z = pk2(s[4 * 33], s[5 * 33]); o.w = pk2(s[6 * 33], s[7 * 33]);
        *(v4u*)(WT + (size_t)(dst_row0 + n) * Kd + k0 + 8 * c) = o; }
    LDS_WAIT(); asm volatile("" ::: "memory");
}

__device__ __forceinline__ void norm_mod_pass(const float* xlat, float* xctx, const float* gvec, const float* modL, int ch_sh, int ch_sc, bf16* H, int nrows, int gw, int NGW, int lane, const bf16* x1a, const bf16* x1b, const float* P, int nsplit, const float* pgate) {
    const int nrows_main = (nsplit > 0 && nrows > TLAT) ? TLAT : nrows;
    for (int chk = gw; chk < nrows_main / 16; chk += NGW) {
        const int r0 = chk * 16; const int j = r0 < TLAT ? r0 / SEQ : 4;
        const float* sc = modL + j * 6144 + ch_sc * 1024; const float* sh = modL + j * 6144 + ch_sh * 1024;
        f32x4 gm[4], sv[4];
#pragma unroll
        for (int jj = 0; jj < 4; ++jj) { const int c = 4 * lane + 256 * jj; gm[jj] = *(const f32x4*)(gvec + c) * (*(const f32x4*)(sc + c) + 1.0f); sv[jj] = *(const f32x4*)(sh + c); }
        f32x4 v[4], vn[4];
#define NROW_LOAD(dst, r_) do { if (x1a != nullptr && (r_) < TLAT) { const bf16* xb_ = (r_) < X1_SPLIT ? x1a + (size_t)(r_) * DM : x1b + (size_t)((r_) - X1_SPLIT) * DM; \
            _Pragma("unroll") for (int jj = 0; jj < 4; ++jj) { const v2u w_ = *(const v2u*)(xb_ + 4 * lane + 256 * jj); dst[jj] = (f32x4){bflo(w_.x), bfhi(w_.x), bflo(w_.y), bfhi(w_.y)}; } } \
          else { const float* xr_ = (r_) < TLAT ? xlat + (size_t)(r_) * DM : xctx + (size_t)((r_) - TLAT) * DM; _Pragma("unroll") for (int jj = 0; jj < 4; ++jj) dst[jj] = *(const f32x4*)(xr_ + 4 * lane + 256 * jj); } } while (0)
        NROW_LOAD(v, r0);
        for (int rr = 0; rr < 16; ++rr) { const int r = r0 + rr;
            if (rr + 1 < 16) { const int r1 = r + 1; NROW_LOAD(vn, r1); }
            float ss = 0.f;
#pragma unroll
            for (int jj = 0; jj < 4; ++jj) ss += (v[jj].x * v[jj].x + v[jj].y * v[jj].y) + (v[jj].z * v[jj].z + v[jj].w * v[jj].w);
            ss = wave_sum(ss); const float rs = 1.0f / sqrtf(ss * (1.0f / DM) + EPSN);
#pragma unroll
            for (int jj = 0; jj < 4; ++jj) { const f32x4 o = v[jj] * rs * gm[jj] + sv[jj]; v2u w; w.x = pk2(o.x, o.y); w.y = pk2(o.z, o.w);
                *(v2u*)(H + (size_t)r * DM + 4 * lane + 256 * jj) = w; }
#pragma unroll
            for (int jj = 0; jj < 4; ++jj) v[jj] = vn[jj];
        }
    }
    if (nrows_main < nrows) {
        const float* sc = modL + 4 * 6144 + ch_sc * 1024; const float* sh = modL + 4 * 6144 + ch_sh * 1024;
        for (int r = TLAT + gw; r < nrows; r += NGW) {
            f32x4 v[4], pp_[4][11];
#pragma unroll
            for (int jj = 0; jj < 4; ++jj) { const int cidx = 4 * lane + 256 * jj; v[jj] = *(const f32x4*)(xctx + (size_t)(r - TLAT) * DM + cidx);
#pragma unroll
                for (int s = 0; s < 11; ++s) { const int se = s < nsplit ? s : nsplit - 1; pp_[jj][s] = *(const f32x4*)(P + ((size_t)se * TCTX + (r - TLAT)) * DM + cidx); } }
            float ss = 0.f;
#pragma unroll
            for (int jj = 0; jj < 4; ++jj) { const int cidx = 4 * lane + 256 * jj; f32x4 a = (f32x4){0.f, 0.f, 0.f, 0.f};
#pragma unroll
                for (int s = 0; s < 11; ++s) a += pp_[jj][s] * (s < nsplit ? 1.f : 0.f);
                v[jj] += *(const f32x4*)(pgate + cidx) * a; *(f32x4*)(xctx + (size_t)(r - TLAT) * DM + cidx) = v[jj];
                ss += (v[jj].x * v[jj].x + v[jj].y * v[jj].y) + (v[jj].z * v[jj].z + v[jj].w * v[jj].w); }
            ss = wave_sum(ss); const float rs = 1.0f / sqrtf(ss * (1.0f / DM) + EPSN);
#pragma unroll
            for (int jj = 0; jj < 4; ++jj) { const int cidx = 4 * lane + 256 * jj; const f32x4 gmv = *(const f32x4*)(gvec + cidx) * (*(const f32x4*)(sc + cidx) + 1.0f);
                const f32x4 o = v[jj] * rs * gmv + *(const f32x4*)(sh + cidx); v2u w; w.x = pk2(o.x, o.y); w.y = pk2(o.z, o.w);
                *(v2u*)(H + (size_t)r * DM + cidx) = w; }
        }
    }
}

__device__ __forceinline__ float rope_lane(float v, int n, int lane, const float* rope) {
    const int axis = lane >> 5, half = (lane >> 4) & 1, f = lane & 15; const int pos = axis ? (n & 63) : (n >> 6);
    const float c = rope[(pos * 16 + f) * 2], s = rope[(pos * 16 + f) * 2 + 1];
    const float partner = __shfl_xor(v, 16);
    return half ? v * c + partner * s : v * c - partner * s;
}

__device__ __forceinline__ void prep_tokens(const bf16* Y, bf16* MIX, const float* scw, int tb, int te, int wi, int ws_, int lane) {
    int inp_ = INP; asm volatile("" : "+s"(inp_));
    const int ch = 4 * lane, grp = lane >> 4, hw = 1 << grp;
    const f32x4 cw0 = *(const f32x4*)(scw + ch), cw1 = *(const f32x4*)(scw + 256 + ch), cw2 = *(const f32x4*)(scw + 512 + ch);
    for (int t0 = tb + wi * 4; t0 < te; t0 += ws_ * 4)
    for (int ti = 0; ti < 4; ++ti) { const int t = t0 + ti;
        const bf16* y = Y + (size_t)t * INP; const bool lat = t < TLAT; const int n = lat ? (t & (SEQ - 1)) : ((t - TLAT) & (CTXL - 1)); const int len = lat ? SEQ : CTXL;
        const bool hp = n > 0, hn = n < len - 1; const long op = hp ? -(long)inp_ : 0, on = hn ? (long)inp_ : 0; const float fp = hp ? 1.f : 0.f, fn = hn ? 1.f : 0.f;
        const v2u gb = *(const v2u*)(y + 704 + ch), c1 = *(const v2u*)(y + 960 + ch), i1 = *(const v2u*)(y + 1216 + ch);
        const v2u c0 = *(const v2u*)(y + op + 960 + ch), i0 = *(const v2u*)(y + op + 1216 + ch), c2 = *(const v2u*)(y + on + 960 + ch), i2 = *(const v2u*)(y + on + 1216 + ch);
        v2u pv[16]; float pw[16];
#pragma unroll
        for (int d = -8; d < 8; ++d) { const int s = n + d; const bool ok = d >= -hw && d < hw && s >= 0 && s < len; pw[d + 8] = ok ? 1.f : 0.f;
            pv[d + 8] = *(const v2u*)(y + (ok ? (long)d * inp_ : 0) + 448 + ch); }
        { const f32x4 w0 = cw0 * fp, w2 = cw2 * fn;
          const float o0 = bflo(gb.x) * (w0.x * bflo(c0.x) * bflo(i0.x) + cw1.x * bflo(c1.x) * bflo(i1.x) + w2.x * bflo(c2.x) * bflo(i2.x));
          const float o1 = bfhi(gb.x) * (w0.y * bfhi(c0.x) * bfhi(i0.x) + cw1.y * bfhi(c1.x) * bfhi(i1.x) + w2.y * bfhi(c2.x) * bfhi(i2.x));
          const float o2 = bflo(gb.y) * (w0.z * bflo(c0.y) * bflo(i0.y) + cw1.z * bflo(c1.y) * bflo(i1.y) + w2.z * bflo(c2.y) * bflo(i2.y));
          const float o3 = bfhi(gb.y) * (w0.w * bfhi(c0.y) * bfhi(i0.y) + cw1.w * bfhi(c1.y) * bfhi(i1.y) + w2.w * bfhi(c2.y) * bfhi(i2.y));
          v2u w; w.x = pk2(o0, o1); w.y = pk2(o2, o3); *(v2u*)(MIX + (size_t)t * DM + 768 + ch) = w; }
        { float s0 = 0.f, s1 = 0.f, s2 = 0.f, s3 = 0.f;
#pragma unroll
          for (int j = 0; j < 16; ++j) { s0 += pw[j] * bflo(pv[j].x); s1 += pw[j] * bfhi(pv[j].x); s2 += pw[j] * bflo(pv[j].y); s3 += pw[j] * bfhi(pv[j].y); }
          const int lo = (n - hw) > 0 ? (n - hw) : 0, hi = (n + hw) < len ? (n + hw) : len; const float icnt = 1.0f / (float)(hi - lo);
          const v2u pc = pv[8];
          v2u w; w.x = pk2(s0 * icnt - bflo(pc.x), s1 * icnt - bfhi(pc.x)); w.y = pk2(s2 * icnt - bflo(pc.y), s3 * icnt - bfhi(pc.y)); *(v2u*)(MIX + (size_t)t * DM + 512 + ch) = w; }
    }
}

__global__ void __launch_bounds__(512) mega(Params p) {
    extern __shared__ __attribute__((aligned(16))) unsigned char lds[];
    cg::grid_group grid = cg::this_grid();
    CParams* pp = (CParams*)__builtin_amdgcn_kernarg_segment_ptr();
    const int ph_lo = pp->ph_lo, ph_hi = pp->ph_hi;
    { const int t0 = tidx(); volatile LAS unsigned* bar_st0 = (volatile LAS unsigned*)((LAS unsigned char*)lds + LDS_ST_OFF); unsigned* barw0 = (unsigned*)(pp->ws + WS_BAR);
      if (t0 < 2) bar_st0[t0] = 0u;
      if (blockIdx.x == 0) for (int i = t0; i < XCD_BAR_WORDS; i += 512) barw0[i] = 0u;
      __syncthreads(); }
    for (int ph = ph_lo; ph < ph_hi; ++ph) {
        asm volatile("" : "+s"(pp));
#define p (*pp)
        const int G = gridDim.x, bx = blockIdx.x;
        const int vcu = (G % 8 == 0) ? (bx % 8) * (G / 8) + bx / 8 : bx;
#define DEF_TID const int tid = tidx(), lane = tid & 63, wave = __builtin_amdgcn_readfirstlane(tid >> 6); const int gw = bx * 8 + wave, NGW = G * 8; (void)tid; (void)lane; (void)gw; (void)NGW;
        unsigned char* ws = p.ws;
        float* mod = (float*)(ws + WS_MOD); float* rope = (float*)(ws + WS_ROPE); float* XC = (float*)(ws + WS_XC);
        bf16* Wb = (bf16*)(ws + WS_W); bf16* H = (bf16*)(ws + WS_H); bf16* Y = (bf16*)(ws + WS_Y); bf16* QL = (bf16*)(ws + WS_QL); bf16* KVL = (bf16*)(ws + WS_KVL);
        bf16* Q = (bf16*)(ws + WS_Q); bf16* KV = (bf16*)(ws + WS_KV); bf16* KR = (bf16*)(ws + WS_KR); bf16* MIX = (bf16*)(ws + WS_MIX); bf16* HID = (bf16*)(ws + WS_HID);
        float* GE = (float*)(ws + WS_EDGE); float* PE = GE + EDGE_N; float* UE = PE + EDGE_N;
        float* out = p.out; float* PART_WO = (float*)(ws + WS_PART_WO); float* PART_DN = (float*)(ws + WS_PART_DN); bf16* X1A = (bf16*)(ws + WS_X1A); bf16* X1B = (bf16*)(ws + WS_X1B);

        if (ph == 0) { { DEF_TID
            LAS float* sv = (LAS float*)lds; LAS float* red = (LAS float*)(lds + 20480);
            for (int i = tid; i < 5 * 1024; i += 512) { const float v = i < 4096 ? p.in[1][i] : p.in[3][i - 4096]; sv[i] = v / (1.f + __expf(-v)); }
            __syncthreads();
            for (int it = bx; it < DEPTH * 96; it += G) {
                const int i = it / 96, nb = it % 96; const float* Wp = p.in[4] + (size_t)i * 1024 * 6144 + nb * 64 + lane;
                float a0 = 0.f, a1 = 0.f, a2 = 0.f, a3 = 0.f, a4 = 0.f;
#pragma unroll 8
                for (int kk = 0; kk < 128; ++kk) { const int k = wave * 128 + kk; const float w = Wp[(size_t)k * 6144];
                    a0 += sv[k] * w; a1 += sv[1024 + k] * w; a2 += sv[2048 + k] * w; a3 += sv[3072 + k] * w; a4 += sv[4096 + k] * w; }
                red[(wave * 5 + 0) * 64 + lane] = a0; red[(wave * 5 + 1) * 64 + lane] = a1; red[(wave * 5 + 2) * 64 + lane] = a2; red[(wave * 5 + 3) * 64 + lane] = a3; red[(wave * 5 + 4) * 64 + lane] = a4;
                __syncthreads();
                if (tid < 320) { const int j = tid >> 6, l = tid & 63; float s = 0.f;
#pragma unroll
                    for (int w = 0; w < 8; ++w) s += red[(w * 5 + j) * 64 + l];
                    mod[((size_t)i * 5 + j) * 6144 + nb * 64 + l] = s + p.in[5][(size_t)i * 6144 + nb * 64 + l]; }
                __syncthreads();
            }
            { const int gt = bx * 512 + tid;
              if (gt < 2048) { const int pos = gt >> 4, f = gt & 15; const float inv = exp2f(-(float)f * (13.287712379549449f / 16.f)); const float ang = (float)pos * inv;
                  const float rev = ang * 0.15915494309189535f; const float fr = rev - rintf(rev);
                  rope[gt * 2] = __builtin_amdgcn_cosf(fr); rope[gt * 2 + 1] = __builtin_amdgcn_sinf(fr); }
              for (int i = gt; i < TCTX * DM / 4; i += G * 512) ((f32x4*)XC)[i] = ((const f32x4*)p.in[2])[i];
              unsigned zz = 0u; asm volatile("" : "+v"(zz));
              for (int i = gt; i < DEPTH * 8192; i += G * 512) { const int l = i >> 13, r = i & 8191;
                  *(v4u*)(Wb + (size_t)l * W_LAYER + WO_IN + (size_t)INW * DM + (size_t)r * 8) = (v4u){zz, zz, zz, zz}; } }
            LAS float* scr = (LAS float*)(lds + 32768 + wave * 8448);
            for (int it = gw; it < DEPTH * 5632; it += NGW) {
                const int l = it / 5632; int r = it % 5632; bf16* WL = Wb + (size_t)l * W_LAYER;
                if (r < 736) { const int kb = r / 46, nb = r % 46; tr_item(p.in[8] + (size_t)l * DM * INW, INW, kb * 64, nb * 32, WL + WO_IN, DM, nb * 32, scr, lane, false, nullptr, nullptr); continue; } r -= 736;
                if (r < 96) { const int kb = r / 24, nb = r % 24; tr_item(p.in[11] + (size_t)l * QRK * 768, 768, kb * 64, nb * 32, WL + WO_Q, QRK, nb * 32, scr, lane, false, nullptr, nullptr); continue; } r -= 96;
                if (r < 64) { const int kb = r / 32, nb = r % 32; tr_item(p.in[12] + (size_t)l * KVRK * 1024, 1024, kb * 64, nb * 32, WL + WO_KV, KVRK, nb * 32, scr, lane, false, nullptr, nullptr); continue; } r -= 64;
                if (r < 512) { const int kb = r / 32, nb = r % 32; const bool fold = (kb >= 8 && kb < 12); const int g = kb - 8;
                    tr_item(p.in[20] + (size_t)l * DM * DM, DM, kb * 64, nb * 32, WL + WO_O, DM, nb * 32, scr, lane, fold, p.in[17] + (size_t)l * 16384 + (fold ? g * 4096 : 0), p.in[18] + (size_t)l * 256 + (fold ? g * 64 : 0)); continue; } r -= 512;
                if (r < 2816) { const int kb = r / 176, nb = r % 176; const int n0 = nb * 32, half = n0 >= DFF ? 1 : 0, ch = n0 - half * DFF; const int drow = 256 * (ch >> 7) + 128 * half + (ch & 127);
                    tr_item(p.in[21] + (size_t)l * DM * 2 * DFF, 2 * DFF, kb * 64, n0, WL + WO_UP, DM, drow, scr, lane, false, nullptr, nullptr); continue; } r -= 2816;
                { const int kb = r / 32, nb = r % 32; tr_item(p.in[23] + (size_t)l * DFF * DM, DM, kb * 64, nb * 32, WL + WO_DN, DFF, nb * 32, scr, lane, false, nullptr, nullptr); }
            }
        } } else {
            const int L = (ph - 1) / 10, k10 = (ph - 1) % 10, k = k10 < 4 ? k10 : k10 + 1;
            const bf16* WL = Wb + (size_t)L * W_LAYER;
            const float* modL = mod + (size_t)L * 5 * 6144;
            const float* xlat = (L == 0) ? p.in[0] : out; const float* xctx = XC;
            const int Mact = (L == DEPTH - 1) ? TLAT : TT;
            if (k == 0) { DEF_TID
                norm_mod_pass(xlat, XC, p.in[6] + L * DM, modL, 0, 1, H, TT, gw, NGW, lane, nullptr, nullptr, PART_DN, (L > 0) ? DFF / 256 : 0, modL - 5 * 6144 + 4 * 6144 + 5 * 1024);
            } else if (k == 2 && bx >= NCTXU) { DEF_TID
                prep_tokens(Y, MIX, p.in[19] + L * 3 * 256, 0, TLAT, (bx - NCTXU) * 8 + wave, (G - NCTXU) * 8, lane);
            } else if (k == 4) { DEF_TID
                const float* kn_g = p.in[15] + L * 128; const int hh = lane >> 4, dd = (lane & 15) * 8;
                const f32x4 kga = *(const f32x4*)(kn_g + dd), kgb = *(const f32x4*)(kn_g + dd + 4);
                for (int t0 = gw * 4; t0 < TT; t0 += NGW * 4) {
                    v4u rk[4];
#pragma unroll
                    for (int ti = 0; ti < 4; ++ti) rk[ti] = *(const v4u*)(KV + (size_t)(t0 + ti) * 1024 + hh * 256 + dd);
#pragma unroll
                    for (int ti = 0; ti < 4; ++ti) {
                        const float f0 = bflo(rk[ti].x), f1 = bfhi(rk[ti].x), f2 = bflo(rk[ti].y), f3 = bfhi(rk[ti].y), f4 = bflo(rk[ti].z), f5 = bfhi(rk[ti].z), f6 = bflo(rk[ti].w), f7 = bfhi(rk[ti].w);
                        float ss = ((f0 * f0 + f1 * f1) + (f2 * f2 + f3 * f3)) + ((f4 * f4 + f5 * f5) + (f6 * f6 + f7 * f7));
                        ss += __builtin_bit_cast(float, __builtin_amdgcn_update_dpp(0, __builtin_bit_cast(int, ss), 0xB1, 0xF, 0xF, true));
                        ss += __builtin_bit_cast(float, __builtin_amdgcn_update_dpp(0, __builtin_bit_cast(int, ss), 0x4E, 0xF, 0xF, true));
                        ss += __builtin_bit_cast(float, __builtin_amdgcn_update_dpp(0, __builtin_bit_cast(int, ss), 0x141, 0xF, 0xF, true));
                        ss += __builtin_bit_cast(float, __builtin_amdgcn_update_dpp(0, __builtin_bit_cast(int, ss), 0x140, 0xF, 0xF, true));
                        const float rs = 1.0f / sqrtf(ss * (1.0f / 128) + EPSN);
                        v4u w; w.x = pk2(f0 * rs * kga.x, f1 * rs * kga.y); w.y = pk2(f2 * rs * kga.z, f3 * rs * kga.w); w.z = pk2(f4 * rs * kgb.x, f5 * rs * kgb.y); w.w = pk2(f6 * rs * kgb.z, f7 * rs * kgb.w);
                        *(v4u*)(KV + (size_t)(t0 + ti) * 1024 + hh * 256 + dd) = w; }
                }
            } else if (k == 5) {
                const int NU = 512 + (L < DEPTH - 1 ? 16 : 0);
                for (int u = vcu; u < NU; u += G) {
                    int b, h, row0, lat0, nlat, ctx0, seq;
                    if (u < 512) { const int bh = u >> 5, qb = u & 31; b = bh >> 2; h = bh & 3; row0 = b * SEQ + qb * 256; lat0 = b * SEQ; nlat = SEQ; ctx0 = TLAT + b * CTXL; seq = SEQ + CTXL; }
                    else { const int j = u - 512; b = j >> 2; h = j & 3; row0 = TLAT + b * CTXL; lat0 = 0; nlat = 0; ctx0 = TLAT + b * CTXL; seq = CTXL; }
                    att::attn_unit(Q + (size_t)row0 * 768 + h * DQK, KV + h * 256, KR, MIX + (size_t)row0 * DM + h * 128, lat0, nlat, ctx0, seq, (char*)lds,
                                   p.in[13] + L * 128, p.in[14] + L * 64, rope, u < 512 ? (u & 31) * 256 : -1);
                    __syncthreads();
                }
            } else if (k == 7) { DEF_TID
                norm_mod_pass(out, XC, p.in[7] + L * DM, modL, 3, 4, H, Mact, gw, NGW, lane, X1A, X1B, PART_WO, (L < DEPTH - 1) ? DM / 128 : 0, modL + 4 * 6144 + 2 * 1024);
            } else if (k == 9) { DEF_TID
                const float* cw = p.in[22] + (size_t)L * 3 * DFF; const int nblk = Mact / 64;
                for (int i = bx * 512 + tid; i < nblk * 2 * (DFF / 4); i += G * 512) {
                    const int c = (i % (DFF / 4)) * 4, be = i / (DFF / 4), blk = be >> 1, e = be & 1; const int r = blk * 64 + (e ? 63 : 0);
                    f32x4 conv = *(const f32x4*)(PE + (size_t)be * DFF + c);
                    if (e == 0) { const bool start = r < TLAT ? ((r & (SEQ - 1)) == 0) : (((r - TLAT) & (CTXL - 1)) == 0);
                        if (!start) conv += *(const f32x4*)(cw + c) * *(const f32x4*)(GE + ((size_t)(blk - 1) * 2 + 1) * DFF + c); }
                    else { const int r1 = r + 1; const bool end = r1 < TLAT ? ((r1 & (SEQ - 1)) == 0) : (((r1 - TLAT) & (CTXL - 1)) == 0);
                        if (!end) conv += *(const f32x4*)(cw + 2 * DFF + c) * *(const f32x4*)(GE + ((size_t)(blk + 1) * 2) * DFF + c); }
                    const f32x4 uu = *(const f32x4*)(UE + (size_t)be * DFF + c);
                    v2u w; w.x = pk2(conv.x * __builtin_amdgcn_rcpf(1.f + __expf(-conv.x)) * uu.x, conv.y * __builtin_amdgcn_rcpf(1.f + __expf(-conv.y)) * uu.y);
                    w.y = pk2(conv.z * __builtin_amdgcn_rcpf(1.f + __expf(-conv.z)) * uu.z, conv.w * __builtin_amdgcn_rcpf(1.f + __expf(-conv.w)) * uu.w);
                    *(v2u*)(HID + (size_t)r * DFF + c) = w;
                }
            } else {
                const bool split_ctx = (k == 6 || k == 10) && L < DEPTH - 1;
                const int ng = (k == 3 || split_ctx) ? 2 : 1;
                for (int gi = 0; gi < ng; ++gi) {
                    pg8::Gemm g; pg8::EpiAll E; E.a1 = nullptr; E.a2 = nullptr; E.a3 = nullptr; E.a4 = nullptr; E.ldc = 0; E.x1a = X1A; E.x1b = X1B; int nsplit = 1, pm0 = 0;
                    if (k == 1 || k == 2) { g = pg8::Gemm{H, WL + WO_IN, k == 1 ? TLAT : TCTX, INP, DM, DM}; if (k == 2) pm0 = TLAT / 256; E.mode = 5; E.a0 = ws; E.a1 = p.in[9] + L * QRK; E.a2 = p.in[10] + L * KVRK; E.a3 = p.in[16] + L * 64; }
                    else if (k == 3 && gi == 0) { g = pg8::Gemm{QL, WL + WO_Q, TT, 768, QRK, QRK};   E.mode = 0; E.a0 = Q; E.ldc = 768; }
                    else if (k == 3) { g = pg8::Gemm{KVL, WL + WO_KV, TT, 1024, KVRK, KVRK}; E.mode = 4; E.a0 = KV; E.a1 = p.in[15] + L * 128; }
                    else if (k == 6 && gi == 0) { g = pg8::Gemm{MIX, WL + WO_O, TLAT, DM, DM, DM};    E.mode = 1; E.ldc = 2; E.a0 = xlat; E.a1 = XC; E.a2 = out; E.a3 = XC; E.a4 = modL + 2 * 1024; }
                    else if (k == 6) { g = pg8::Gemm{MIX, WL + WO_O, TCTX, DM, 128, DM}; nsplit = DM / 128; pm0 = TLAT / 256; E.mode = 3; E.a0 = nullptr; E.a3 = PART_WO; }
                    else if (k == 8) { g = pg8::Gemm{H, WL + WO_UP, Mact, 2 * DFF, DM, DM}; E.mode = 2; E.a0 = HID; E.a1 = p.in[22] + (size_t)L * 3 * DFF; E.a2 = GE; }
                    else if (gi == 0) { g = pg8::Gemm{HID, WL + WO_DN, TLAT, DM, DFF, DFF};  E.mode = 1; E.ldc = 1; E.a0 = out; E.a1 = XC; E.a2 = out; E.a3 = XC; E.a4 = modL + 5 * 1024; }
                    else             { g = pg8::Gemm{HID, WL + WO_DN, TCTX, DM, 256, DFF}; nsplit = DFF / 256; pm0 = TLAT / 256; E.mode = 3; E.a0 = nullptr; E.a3 = PART_DN; }
                    pg8::StaticOrder S; S.init(g.M, g.N, G, bx); S.nsplit = nsplit; S.pm0 = pm0;
                    pg8::gemm_phase<pg8::EpiAll, pg8::StaticOrder, true, true>((LAS unsigned char*)lds, g, S, E);
                }
                if (k == 3) { DEF_TID prep_tokens(Y, MIX, p.in[19] + L * 3 * 256, TLAT, TT, gw, NGW, lane); }
            }
        }
        if (ph + 1 < ph_hi) {
            volatile LAS unsigned* bar_st = (volatile LAS unsigned*)((LAS unsigned char*)lds + LDS_ST_OFF); unsigned* barw = (unsigned*)(pp->ws + WS_BAR);
            if (ph == ph_lo) { grid.sync(); (void)xcd_barrier_post(barw, bar_st); }
            else { XcdBarrier xb; xb.bar = barw; xb.x = xb_xcc_id(); xb.st = bar_st; xcd_barrier(xb); } }
#undef p
    }
}

extern "C" void kernel_launch(void* const* d_in, const int* in_sizes, int n_in, void* d_out, int out_size, void* d_ws, size_t ws_size, hipStream_t stream) {
    static int grid = 0;
    if (grid == 0) {
        if (n_in != 24 || in_sizes[0] != TLAT * DM || out_size != TLAT * DM || ws_size < WS_END) { fprintf(stderr, "kernel_launch: unexpected shapes (n_in %d, ws %zu)\n", n_in, ws_size); grid = -1; return; }
        int dev = 0, cus = 0, per_cu = 0;
        hipGetDevice(&dev); hipDeviceGetAttribute(&cus, hipDeviceAttributeMultiprocessorCount, dev);
        if (hipFuncSetAttribute((const void*)mega, hipFuncAttributeMaxDynamicSharedMemorySize, LDS_BYTES) != hipSuccess) { fprintf(stderr, "kernel_launch: hipFuncSetAttribute failed\n"); grid = -1; return; }
        if (hipOccupancyMaxActiveBlocksPerMultiprocessor(&per_cu, (const void*)mega, 512, LDS_BYTES) != hipSuccess || per_cu < 1) { fprintf(stderr, "kernel_launch: occupancy query says %d\n", per_cu); per_cu = 1; }
        (void)hipGetLastError();
        grid = cus;
    }
    if (grid < 0) return;
    Params p{};
    for (int i = 0; i < 24; ++i) p.in[i] = (const float*)d_in[i];
    p.out = (float*)d_out; p.ws = (unsigned char*)d_ws;
    p.ph_lo = 0; p.ph_hi = NPH;
    void* args[] = {&p};
    hipError_t e = hipLaunchCooperativeKernel((const void*)mega, dim3(grid), dim3(512), args, LDS_BYTES, stream);
    if (e != hipSuccess) fprintf(stderr, "cooperative launch failed: %s (grid %d)\n", hipGetErrorString(e), grid);
}
```
